# Optimizing an MI355X kernel written in HIP

```python
import math
import jax, jax.numpy as jnp
from jax import lax
import numpy as np

D_MODEL = 1024
BATCH = 4
SEQ = 4096
DEPTH = 1
DEC_BATCH = 8
DEC_SEQ = 2048
PAST_LEN = 128

HEAD_DIM = 64
N_HEADS_A = 8
N_HEADS_B = 8
N_KV_B = 2
WIDTH_A = N_HEADS_A * HEAD_DIM
WIDTH_B = N_HEADS_B * HEAD_DIM
KV_WIDTH_B = N_KV_B * HEAD_DIM
MIX_WIDTH = WIDTH_A + WIDTH_B
DILATED_PATTERNS = ((128, 1), (512, 4), (2048, 16))
GRID_W = 64
ROPE_THETA = 10000.0
Q_BLOCK = 128
LN_EPS = 1e-5
RMS_EPS = 1e-6
NEG_BIG = -1e30
DEEPNORM_ALPHA = (2.0 * DEPTH) ** 0.25
DEEPNORM_BETA = (8.0 * DEPTH) ** -0.25
IN_SIZES = (WIDTH_A, WIDTH_A, WIDTH_A, WIDTH_A, WIDTH_B, KV_WIDTH_B, KV_WIDTH_B, WIDTH_B)
IN_WIDTH = 4 * WIDTH_A + 2 * WIDTH_B + 2 * KV_WIDTH_B
IN_SPLITS = tuple(int(v) for v in np.cumsum(IN_SIZES)[:-1])

kernel_name = "hymba_dilated_gqa_axial_encoder"


def _rope_cos_sin(pos, dim):
    inv_freq = 1.0 / (ROPE_THETA ** (jnp.arange(0, dim, 2, dtype=jnp.float32) / dim))
    ang = pos.astype(jnp.float32)[:, None] * inv_freq[None, :]
    ang = jnp.concatenate([ang, ang], axis=-1)
    return jnp.cos(ang), jnp.sin(ang)


def _rope(x, cos, sin):
    xf = x.astype(jnp.float32)
    x1, x2 = jnp.split(xf, 2, axis=-1)
    rot = jnp.concatenate([-x2, x1], axis=-1)
    return (xf * cos[None, :, None, :] + rot * sin[None, :, None, :]).astype(x.dtype)


def _axial_rope(x, row, col):
    half = x.shape[-1] // 2
    cr, sr = _rope_cos_sin(row, half)
    cc, sc = _rope_cos_sin(col, half)
    return jnp.concatenate([_rope(x[..., :half], cr, sr), _rope(x[..., half:], cc, sc)], axis=-1)


def _rms_norm_heads(x, g):
    xf = x.astype(jnp.float32)
    xf = xf * lax.rsqrt(jnp.mean(xf * xf, axis=-1, keepdims=True) + RMS_EPS)
    return (xf * g.astype(jnp.float32)).astype(x.dtype)


def _dilated_attention(q, k, v):
    b, n, h, dh = q.shape
    scale = dh ** -0.5
    nb = n // Q_BLOCK
    qb = q.reshape(b, nb, Q_BLOCK, h, dh).transpose(1, 0, 2, 3, 4)
    starts = jnp.arange(nb, dtype=jnp.int32) * Q_BLOCK

    def block(args):
        q_blk, start = args
        qpos = start + jnp.arange(Q_BLOCK, dtype=jnp.int32)
        lses, outs = [], []
        for window, dil in DILATED_PATTERNS:
            half = window // (2 * dil)
            offs = dil * jnp.arange(-half, half + 1, dtype=jnp.int32)
            kpos = qpos[:, None] + offs[None, :]
            valid = (kpos >= 0) & (kpos < n)
            kidx = jnp.clip(kpos, 0, n - 1)
            kg = k[:, kidx]
            vg = v[:, kidx]
            s = jnp.einsum('bqhd,bqlhd->bhql', q_blk, kg,
                           preferred_element_type=jnp.float32) * scale
            s = jnp.where(valid[None, None], s, NEG_BIG)
            m = jnp.max(s, axis=-1, keepdims=True)
            p = jnp.exp(s - m)
            den = jnp.sum(p, axis=-1, keepdims=True)
            o = jnp.einsum('bhql,bqlhd->bqhd', p, vg.astype(jnp.float32))
            o = o / jnp.transpose(den, (0, 2, 1, 3))
            lse = jnp.transpose((m + jnp.log(den))[..., 0], (0, 2, 1))
            lses.append(lse)
            outs.append(o)
        w = jax.nn.softmax(jnp.stack(lses, axis=0), axis=0)
        out = jnp.sum(w[..., None] * jnp.stack(outs, axis=0), axis=0)
        return out.astype(q.dtype)

    out = lax.map(block, (qb, starts))
    return out.transpose(1, 0, 2, 3, 4).reshape(b, n, h, dh)


def _gqa_attention(q, k, v):
    b, n, hq, dh = q.shape
    hkv = k.shape[2]
    g = hq // hkv
    scale = dh ** -0.5
    nb = n // Q_BLOCK
    qb = q.reshape(b, nb, Q_BLOCK, hkv, g, dh).transpose(1, 0, 2, 3, 4, 5)

    def block(q_blk):
        s = jnp.einsum('bqkgd,bskd->bkgqs', q_blk, k,
                       preferred_element_type=jnp.float32) * scale
        p = jax.nn.softmax(s, axis=-1)
        o = jnp.einsum('bkgqs,bskd->bqkgd', p, v.astype(jnp.float32))
        return o.astype(q.dtype)

    out = lax.map(block, qb)
    return out.transpose(1, 0, 2, 3, 4, 5).reshape(b, n, hq, dh)


def _layer_norm(x, g, b):
    xf = x.astype(jnp.float32)
    mu = jnp.mean(xf, axis=-1, keepdims=True)
    var = jnp.mean(jnp.square(xf - mu), axis=-1, keepdims=True)
    y = (xf - mu) * lax.rsqrt(var + LN_EPS) * g.astype(jnp.float32) + b.astype(jnp.float32)
    return y.astype(x.dtype)


def _layer(x, w_in, w_out, q_norm, k_norm, ln_g, ln_b):
    b, n, _ = x.shape
    rows = n // GRID_W
    pos = jnp.arange(n, dtype=jnp.int32)
    row = jnp.repeat(jnp.arange(rows, dtype=jnp.int32), GRID_W)
    col = jnp.tile(jnp.arange(GRID_W, dtype=jnp.int32), rows)

    h = jnp.einsum('bnd,de->bne', x, w_in)
    qa, ka, va, ga, qb, kb, vb, gb = jnp.split(h, IN_SPLITS, axis=-1)

    cos, sin = _rope_cos_sin(pos, HEAD_DIM)
    qa = _rope(qa.reshape(b, n, N_HEADS_A, HEAD_DIM), cos, sin)
    ka = _rope(ka.reshape(b, n, N_HEADS_A, HEAD_DIM), cos, sin)
    va = va.reshape(b, n, N_HEADS_A, HEAD_DIM)
    out_a = _dilated_attention(qa, ka, va).reshape(b, n, WIDTH_A) * jax.nn.silu(ga)

    qb = _axial_rope(_rms_norm_heads(qb.reshape(b, n, N_HEADS_B, HEAD_DIM), q_norm), row, col)
    kb = _axial_rope(_rms_norm_heads(kb.reshape(b, n, N_KV_B, HEAD_DIM), k_norm), row, col)
    vb = vb.reshape(b, n, N_KV_B, HEAD_DIM)
    out_b = _gqa_attention(qb, kb, vb).reshape(b, n, WIDTH_B) * jax.nn.silu(gb)

    f = jnp.einsum('bne,ed->bnd', jnp.concatenate([out_a, out_b], axis=-1), w_out)
    return _layer_norm(DEEPNORM_ALPHA * x + f, ln_g, ln_b)


def setup_inputs(seed: int = 0) -> dict:
    key = jax.random.key(seed)
    ks = jax.random.split(key, 8)
    x_prompt = jax.random.normal(ks[0], (BATCH, SEQ, D_MODEL), jnp.float32)
    x_sample = jax.random.normal(ks[1], (DEC_BATCH, DEC_SEQ, D_MODEL), jnp.float32)
    col_scale = np.concatenate([
        np.ones(WIDTH_A), np.ones(WIDTH_A), np.full(WIDTH_A, DEEPNORM_BETA), np.ones(WIDTH_A),
        np.ones(WIDTH_B), np.ones(KV_WIDTH_B), np.full(KV_WIDTH_B, DEEPNORM_BETA), np.ones(WIDTH_B),
    ]).astype(np.float32)
    w_in = jax.random.normal(ks[2], (DEPTH, D_MODEL, IN_WIDTH), jnp.float32) * (D_MODEL ** -0.5)
    w_in = w_in * jnp.asarray(col_scale)[None, None, :]
    w_out = jax.random.normal(ks[3], (DEPTH, MIX_WIDTH, D_MODEL), jnp.float32) * (MIX_WIDTH ** -0.5) * DEEPNORM_BETA
    q_norm = 1.0 + 0.02 * jax.random.normal(ks[4], (DEPTH, HEAD_DIM), jnp.float32)
    k_norm = 1.0 + 0.02 * jax.random.normal(ks[5], (DEPTH, HEAD_DIM), jnp.float32)
    ln_g = 1.0 + 0.02 * jax.random.normal(ks[6], (DEPTH, D_MODEL), jnp.float32)
    ln_b = 0.02 * jax.random.normal(ks[7], (DEPTH, D_MODEL), jnp.float32)
    return {"x_prompt": x_prompt, "x_sample": x_sample, "w_in": w_in, "w_out": w_out,
            "q_norm": q_norm, "k_norm": k_norm, "ln_g": ln_g, "ln_b": ln_b}


def reference(x_prompt, x_sample, w_in, w_out, q_norm, k_norm, ln_g, ln_b):
    y_prompt = x_prompt
    y_sample = x_sample
    for i in range(DEPTH):
        y_prompt = _layer(y_prompt, w_in[i], w_out[i], q_norm[i], k_norm[i], ln_g[i], ln_b[i])
        y_sample = _layer(y_sample, w_in[i], w_out[i], q_norm[i], k_norm[i], ln_g[i], ln_b[i])
    return (y_prompt, y_sample)
```

```cpp
#include <hip/hip_runtime.h>
#include <stdint.h>

typedef unsigned short bf16_t;
typedef float f32x4 __attribute__((ext_vector_type(4)));
typedef unsigned u32x4 __attribute__((ext_vector_type(4)));

constexpr int DM = 1024, M = 32768, MP = 16384, NIN = 3328;
constexpr float C2 = 0.125f * 1.4426950408889634f;
constexpr float ALPHA = 1.189207115002721f;
constexpr size_t MiB = 1u << 20;
constexpr size_t WS_TAB1 = 1 * MiB, WS_TAB2 = 3 * MiB - 65536, WS_WIN = 4 * MiB, WS_WOUT = 12 * MiB;
constexpr size_t WS_QA = 16 * MiB, WS_KA = 48 * MiB, WS_VA = 80 * MiB, WS_QB = 112 * MiB, WS_KB = 144 * MiB, WS_VB = 152 * MiB, WS_MIX = 160 * MiB;

__device__ __forceinline__ unsigned f2bf(float f) { unsigned u = __builtin_bit_cast(unsigned, f); return (u + 0x7fffu + ((u >> 16) & 1u)) >> 16; }
__device__ __forceinline__ float bf2f(unsigned h) { return __builtin_bit_cast(float, h << 16); }
__device__ __forceinline__ unsigned pk2(float lo, float hi) { return f2bf(lo) | (f2bf(hi) << 16); }

__device__ __forceinline__ void tok(int m, int& n, int& t, int& base) {
    if (m < MP) { n = 4096; t = m & 4095; } else { n = 2048; t = (m - MP) & 2047; }
    base = m - t;
}
__host__ __device__ __forceinline__ int axdim(int bj, int w32) { return (w32 < 16 ? w32 : 32 + (w32 - 16)) + 16 * bj; }
__host__ __device__ __forceinline__ int phys2log(int p) {
    const int pn = p >> 8, c = p & 255, bj = c >> 7, wc = (c >> 5) & 3, w32 = c & 31, nat = 32 * bj + w32;
    if (pn < 2) return 0 + 64 * (4 * pn + wc) + nat;
    if (pn < 4) return 512 + 64 * (4 * (pn - 2) + wc) + nat;
    if (pn < 6) return 1024 + 64 * (4 * (pn - 4) + wc) + nat;
    if (pn < 8) return 1536 + 64 * (4 * (pn - 6) + wc) + nat;
    if (pn < 10) return 2048 + 64 * (4 * (pn - 8) + wc) + axdim(bj, w32);
    if (pn < 12) return 2816 + 64 * (4 * (pn - 10) + wc) + nat;
    if (wc < 2) return 2560 + 64 * wc + axdim(bj, w32);
    return 2688 + 64 * (wc - 2) + nat;
}

__global__ void k_tables(float2* tab1, float2* tab2) {
    const int i = blockIdx.x * blockDim.x + threadIdx.x;
    if (i < 4096 * 32) { const int pos = i >> 5, f = i & 31; const double ang = (double)pos * pow(10000.0, -(2.0 * f) / 64.0); tab1[i] = make_float2((float)cos(ang), (float)sin(ang)); }
    if (i < 64 * 16) { const int pos = i >> 4, f = i & 15; const double ang = (double)pos * pow(10000.0, -(2.0 * f) / 32.0); tab2[i] = make_float2((float)cos(ang), (float)sin(ang)); }
}
__global__ void k_cvt_x(const float* xp, const float* xs, bf16_t* xb) {
    const size_t i = ((size_t)blockIdx.x * blockDim.x + threadIdx.x) * 8;
    if (i >= (size_t)M * DM) return;
    const float* src = i < (size_t)MP * DM ? xp + i : xs + (i - (size_t)MP * DM);
    const f32x4 a = *(const f32x4*)src, b = *(const f32x4*)(src + 4);
    u32x4 o; o.x = pk2(a.x, a.y); o.y = pk2(a.z, a.w); o.z = pk2(b.x, b.y); o.w = pk2(b.z, b.w);
    *(u32x4*)(xb + i) = o;
}
template <bool PERM> __global__ void k_cvt_w(const float* W, bf16_t* WT, int K, int N) {
    const int i = blockIdx.x * blockDim.x + threadIdx.x;
    if (i >= K * N) return;
    const int p = i % N, k = i / N;
    WT[(size_t)p * K + k] = (bf16_t)f2bf(W[(size_t)k * N + (PERM ? phys2log(p) : p)]);
}

struct G1Args { const bf16_t* A; const bf16_t* Bt; bf16_t *qa, *ka, *va, *qb, *kb, *vb, *mix; const float2 *tab1, *tab2; const float *qn, *kn; };
struct G2Args { const bf16_t* A; const bf16_t* Bt; const float *xp, *xs; float* out; };

template <int MODE, class Args> __global__ void __launch_bounds__(256) k_gemm(Args a) {
    __shared__ float As[64][33], Bs[64][33], Cs[64][65];
    const int tid = threadIdx.x, tx = tid & 15, ty = tid >> 4;
    const int row0 = blockIdx.x * 64, slot = blockIdx.y;
    const int pn = slot >> 2, wc = slot & 3;
    float acc[4][4];
#pragma unroll
    for (int i = 0; i < 4; ++i)
#pragma unroll
        for (int j = 0; j < 4; ++j) acc[i][j] = 0.f;
    const int lr = tid >> 2, kc = (tid & 3) * 8;
    int bcol;
    if (MODE == 1) bcol = 256 * pn + 128 * (lr >> 5) + 32 * wc + (lr & 31); else bcol = 64 * slot + lr;
    for (int k0 = 0; k0 < DM; k0 += 32) {
        const u32x4 av = *(const u32x4*)(a.A + (size_t)(row0 + lr) * DM + k0 + kc);
        const u32x4 bv = *(const u32x4*)(a.Bt + (size_t)bcol * DM + k0 + kc);
        __syncthreads();
#pragma unroll
        for (int e = 0; e < 4; ++e) { As[lr][kc + 2 * e] = bf2f(av[e] & 0xffffu); As[lr][kc + 2 * e + 1] = bf2f(av[e] >> 16); Bs[lr][kc + 2 * e] = bf2f(bv[e] & 0xffffu); Bs[lr][kc + 2 * e + 1] = bf2f(bv[e] >> 16); }
        __syncthreads();
#pragma unroll 8
        for (int k = 0; k < 32; ++k) {
            float av4[4], bv4[4];
#pragma unroll
            for (int i = 0; i < 4; ++i) { av4[i] = As[4 * ty + i][k]; bv4[i] = Bs[tx + 16 * i][k]; }
#pragma unroll
            for (int i = 0; i < 4; ++i)
#pragma unroll
                for (int j = 0; j < 4; ++j) acc[i][j] += av4[i] * bv4[j];
        }
    }
#pragma unroll
    for (int i = 0; i < 4; ++i)
#pragma unroll
        for (int j = 0; j < 4; ++j) Cs[4 * ty + i][tx + 16 * j] = acc[i][j];
    __syncthreads();
    const int r = tid >> 2, q4 = tid & 3, m = row0 + r;
    if constexpr (MODE == 2) {
        const float* xr = m < MP ? a.xp + (size_t)m * DM : a.xs + (size_t)(m - MP) * DM;
        for (int e = 0; e < 16; ++e) { const int lc = 16 * q4 + e, col = 64 * slot + lc; a.out[(size_t)m * DM + col] = ALPHA * xr[col] + Cs[r][lc]; }
    } else {
        int n, t, base; tok(m, n, t, base);
        int kind, head;
        if (pn < 2) { kind = 0; head = 4 * pn + wc; } else if (pn < 4) { kind = 1; head = 4 * (pn - 2) + wc; } else if (pn < 6) { kind = 2; head = 4 * (pn - 4) + wc; }
        else if (pn < 8) { kind = 3; head = 4 * (pn - 6) + wc; } else if (pn < 10) { kind = 4; head = 4 * (pn - 8) + wc; } else if (pn < 12) { kind = 5; head = 4 * (pn - 10) + wc; }
        else if (wc < 2) { kind = 6; head = wc; } else { kind = 7; head = wc - 2; }
        if (kind == 0 || kind == 1) {
            bf16_t* dst = (kind == 0 ? a.qa : a.ka) + (size_t)m * 512 + head * 64; const float sc = kind == 0 ? C2 : 1.f;
            for (int e = 0; e < 8; ++e) { const int i = 8 * q4 + e; const float2 cs = a.tab1[t * 32 + i]; const float x1 = Cs[r][i], x2 = Cs[r][32 + i];
                dst[i] = (bf16_t)f2bf((x1 * cs.x - x2 * cs.y) * sc); dst[32 + i] = (bf16_t)f2bf((x2 * cs.x + x1 * cs.y) * sc); }
        } else if (kind == 2 || kind == 7) {
            bf16_t* dst = kind == 2 ? a.va + (size_t)m * 512 + head * 64 : a.vb + (size_t)m * 128 + head * 64;
            for (int e = 0; e < 16; ++e) { const int lc = 16 * q4 + e; dst[lc] = (bf16_t)f2bf(Cs[r][lc]); }
        } else if (kind == 3 || kind == 5) {
            bf16_t* dst = a.mix + (size_t)m * DM + (kind == 5 ? 512 : 0) + head * 64;
            for (int e = 0; e < 16; ++e) { const int lc = 16 * q4 + e; const float g = Cs[r][lc]; dst[lc] = (bf16_t)f2bf(g / (1.f + __expf(-g))); }
        } else {
            float ss = 0.f;
            for (int e = 0; e < 16; ++e) { const float v = Cs[r][16 * q4 + e]; ss += v * v; }
            ss += __shfl_xor(ss, 1); ss += __shfl_xor(ss, 2);
            const float rs = 1.0f / sqrtf(ss * (1.f / 64.f) + 1e-6f);
            const float* gn = kind == 4 ? a.qn : a.kn; const float sc = kind == 4 ? C2 : 1.f;
            bf16_t* dst = kind == 4 ? a.qb + (size_t)m * 512 + head * 64 : a.kb + (size_t)m * 128 + head * 64;
            const int prow = t >> 6, pcol = t & 63;
            for (int e = 0; e < 8; ++e) { const int i = 8 * q4 + e, d1 = axdim(0, i), d2 = axdim(1, i);
                const float2 cs = a.tab2[(i < 16 ? prow : pcol) * 16 + (i & 15)];
                const float x1 = Cs[r][i] * rs * gn[d1], x2 = Cs[r][32 + i] * rs * gn[d2];
                dst[d1] = (bf16_t)f2bf((x1 * cs.x - x2 * cs.y) * sc); dst[d2] = (bf16_t)f2bf((x2 * cs.x + x1 * cs.y) * sc); }
        }
    }
}

__global__ void __launch_bounds__(256) k_attn_a(const bf16_t* qa, const bf16_t* ka, const bf16_t* va, bf16_t* mix) {
    const int gid = blockIdx.x * 256 + threadIdx.x; const int h = gid & 7, m = gid >> 3;
    if (m >= M) return;
    int n, t, base; tok(m, n, t, base);
    float q[64], o[64];
    const bf16_t* qp = qa + (size_t)m * 512 + h * 64;
#pragma unroll
    for (int d = 0; d < 64; ++d) { q[d] = bf2f(qp[d]); o[d] = 0.f; }
    float mx = -1e30f, l = 0.f;
    for (int p = 0; p < 3; ++p) { const int dil = p == 0 ? 1 : (p == 1 ? 4 : 16);
        for (int j = -64; j <= 64; ++j) { const int kp = t + dil * j; if (kp < 0 || kp >= n) continue;
            const bf16_t* kr = ka + (size_t)(base + kp) * 512 + h * 64; const bf16_t* vr = va + (size_t)(base + kp) * 512 + h * 64;
            float s = 0.f;
#pragma unroll
            for (int d = 0; d < 64; ++d) s += q[d] * bf2f(kr[d]);
            const float mn = fmaxf(mx, s), f = exp2f(mx - mn), pe = exp2f(s - mn);
            l = l * f + pe;
#pragma unroll
            for (int d = 0; d < 64; ++d) o[d] = o[d] * f + pe * bf2f(vr[d]);
            mx = mn; } }
    bf16_t* mp = mix + (size_t)m * DM + h * 64; const float il = 1.f / l;
#pragma unroll
    for (int d = 0; d < 64; ++d) mp[d] = (bf16_t)f2bf(o[d] * il * bf2f(mp[d]));
}

__global__ void __launch_bounds__(256) k_attn_b(const bf16_t* qb, const bf16_t* kb, const bf16_t* vb, bf16_t* mix) {
    __shared__ float Ks[64][64], Vs[64][64];
    const int tid = threadIdx.x; const int h = blockIdx.y, kvh = h >> 2; const int m = blockIdx.x * 256 + tid;
    int n, t, base; tok(m, n, t, base);
    float q[64], o[64];
    const bf16_t* qp = qb + (size_t)m * 512 + h * 64;
#pragma unroll
    for (int d = 0; d < 64; ++d) { q[d] = bf2f(qp[d]); o[d] = 0.f; }
    float mx = -1e30f, l = 0.f;
    for (int k0 = 0; k0 < n; k0 += 64) {
        __syncthreads();
        { const int kr = tid >> 2, c0 = (tid & 3) * 16; const bf16_t* kp = kb + (size_t)(base + k0 + kr) * 128 + kvh * 64 + c0; const bf16_t* vp = vb + (size_t)(base + k0 + kr) * 128 + kvh * 64 + c0;
            for (int e = 0; e < 16; ++e) { Ks[kr][c0 + e] = bf2f(kp[e]); Vs[kr][c0 + e] = bf2f(vp[e]); } }
        __syncthreads();
        for (int j = 0; j < 64; ++j) {
            float s = 0.f;
#pragma unroll
            for (int d = 0; d < 64; ++d) s += q[d] * Ks[j][d];
            const float mn = fmaxf(mx, s), f = exp2f(mx - mn), pe = exp2f(s - mn);
            l = l * f + pe;
#pragma unroll
            for (int d = 0; d < 64; ++d) o[d] = o[d] * f + pe * Vs[j][d];
            mx = mn;
        }
    }
    bf16_t* mp = mix + (size_t)m * DM + 512 + h * 64; const float il = 1.f / l;
#pragma unroll
    for (int d = 0; d < 64; ++d) mp[d] = (bf16_t)f2bf(o[d] * il * bf2f(mp[d]));
}

__global__ void __launch_bounds__(256) k_ln(float* out, const float* g, const float* b) {
    const int lane = threadIdx.x & 63, row = blockIdx.x * 4 + (threadIdx.x >> 6);
    f32x4* xr = (f32x4*)(out + (size_t)row * DM) + lane;
    f32x4 v[4]; float s = 0.f;
#pragma unroll
    for (int j = 0; j < 4; ++j) { v[j] = xr[64 * j]; s += (v[j].x + v[j].y) + (v[j].z + v[j].w); }
#pragma unroll
    for (int o = 1; o < 64; o <<= 1) s += __shfl_xor(s, o);
    const float mean = s * (1.f / DM); float s2 = 0.f;
#pragma unroll
    for (int j = 0; j < 4; ++j) { v[j] = v[j] - mean; s2 += (v[j].x * v[j].x + v[j].y * v[j].y) + (v[j].z * v[j].z + v[j].w * v[j].w); }
#pragma unroll
    for (int o = 1; o < 64; o <<= 1) s2 += __shfl_xor(s2, o);
    const float rstd = 1.f / sqrtf(s2 * (1.f / DM) + 1e-5f);
#pragma unroll
    for (int j = 0; j < 4; ++j) { const f32x4 gg = ((const f32x4*)g)[lane + 64 * j], bb = ((const f32x4*)b)[lane + 64 * j]; xr[64 * j] = v[j] * rstd * gg + bb; }
}

extern "C" void kernel_launch(void* const* d_in, const int* in_sizes, int n_in, void* d_out, int out_size, void* d_ws, size_t ws_size, hipStream_t stream) {
    const float* xp = (const float*)d_in[0]; const float* xs = (const float*)d_in[1]; const float* win = (const float*)d_in[2]; const float* wout = (const float*)d_in[3];
    const float* qn = (const float*)d_in[4]; const float* kn = (const float*)d_in[5]; const float* lng = (const float*)d_in[6]; const float* lnb = (const float*)d_in[7];
    unsigned char* ws = (unsigned char*)d_ws; float* out = (float*)d_out;
    float2* tab1 = (float2*)(ws + WS_TAB1); float2* tab2 = (float2*)(ws + WS_TAB2);
    bf16_t* winT = (bf16_t*)(ws + WS_WIN); bf16_t* woutT = (bf16_t*)(ws + WS_WOUT); bf16_t* xb = (bf16_t*)d_out;
    bf16_t *qa = (bf16_t*)(ws + WS_QA), *ka = (bf16_t*)(ws + WS_KA), *va = (bf16_t*)(ws + WS_VA), *qb = (bf16_t*)(ws + WS_QB), *kb = (bf16_t*)(ws + WS_KB), *vb = (bf16_t*)(ws + WS_VB), *mix = (bf16_t*)(ws + WS_MIX);
    k_tables<<<512, 256, 0, stream>>>(tab1, tab2);
    k_cvt_x<<<(M * (DM / 8)) / 256, 256, 0, stream>>>(xp, xs, xb);
    k_cvt_w<true><<<(DM * NIN + 255) / 256, 256, 0, stream>>>(win, winT, DM, NIN);
    k_cvt_w<false><<<(DM * DM + 255) / 256, 256, 0, stream>>>(wout, woutT, DM, DM);
    G1Args g1{xb, winT, qa, ka, va, qb, kb, vb, mix, tab1, tab2, qn, kn};
    k_gemm<1, G1Args><<<dim3(M / 64, 52), 256, 0, stream>>>(g1);
    k_attn_a<<<(M * 8) / 256, 256, 0, stream>>>(qa, ka, va, mix);
    k_attn_b<<<dim3(M / 256, 8), 256, 0, stream>>>(qb, kb, vb, mix);
    G2Args g2{mix, woutT, xp, xs, out};
    k_gemm<2, G2Args><<<dim3(M / 64, 16), 256, 0, stream>>>(g2);
    k_ln<<<M / 4, 256, 0, stream>>>(out, lng, lnb);
}
```

```cpp
#include <hip/hip_runtime.h>
#include <hip/hip_bf16.h>
#include <cstdio>
#include <cstdint>
#include <cmath>

constexpr int DM = 1024, M = 32768, MP = 16384, NIN = 3328;
constexpr float C2 = 0.125f * 1.4426950408889634f;
constexpr float ALPHA = 1.189207115002721f;
constexpr float LN_EPS = 1e-5f, RMS_EPS = 1e-6f;
constexpr size_t MiB = 1u << 20;
constexpr size_t WS_CTL = 0, CTL_ZERO_BYTES = 1 * MiB;
constexpr size_t WS_TAB1 = 1 * MiB, WS_TAB2 = 3 * MiB - 65536, WS_WIN = 4 * MiB, WS_WOUT = 12 * MiB;
constexpr size_t WS_QA = 16 * MiB, WS_KA = 48 * MiB, WS_VA = 80 * MiB, WS_QB = 112 * MiB, WS_KB = 144 * MiB, WS_VB = 152 * MiB, WS_MIX = 160 * MiB, WS_END = 224 * MiB;
constexpr size_t DO_XB = 0, DO_PO = 0, DO_LSE = 96 * MiB, PO_STRIDE = (size_t)M * 512  , LSE_STRIDE = (size_t)M * 8;

typedef unsigned short bf16_t;
__device__ __forceinline__ unsigned f2bf(float f) { unsigned u = __builtin_bit_cast(unsigned, f); return (u + 0x7fffu + ((u >> 16) & 1u)) >> 16; }
__device__ __forceinline__ float bf2f(unsigned h) { return __builtin_bit_cast(float, h << 16); }
__device__ __forceinline__ unsigned pk2(float lo, float hi) { return f2bf(lo) | (f2bf(hi) << 16); }
__device__ __forceinline__ float bflo(unsigned w) { return __builtin_bit_cast(float, w << 16); }
__device__ __forceinline__ float bfhi(unsigned w) { return __builtin_bit_cast(float, w & 0xffff0000u); }
__device__ __forceinline__ void tok(int m, int& n, int& t, int& base) {
    if (m < MP) { n = 4096; t = m & 4095; } else { n = 2048; t = (m - MP) & 2047; }
    base = m - t;
}
__host__ __device__ __forceinline__ int axdim(int bj, int w32) { return (w32 < 16 ? w32 : 32 + (w32 - 16)) + 16 * bj; }
__host__ __device__ __forceinline__ int phys2log(int p) {
    const int pn = p >> 8, c = p & 255, bj = c >> 7, wc = (c >> 5) & 3, w32 = c & 31, nat = 32 * bj + w32;
    if (pn < 2) return 0 + 64 * (4 * pn + wc) + nat;
    if (pn < 4) return 512 + 64 * (4 * (pn - 2) + wc) + nat;
    if (pn < 6) return 1024 + 64 * (4 * (pn - 4) + wc) + nat;
    if (pn < 8) return 1536 + 64 * (4 * (pn - 6) + wc) + nat;
    if (pn < 10) return 2048 + 64 * (4 * (pn - 8) + wc) + axdim(bj, w32);
    if (pn < 12) return 2816 + 64 * (4 * (pn - 10) + wc) + nat;
    if (wc < 2) return 2560 + 64 * wc + axdim(bj, w32);
    return 2688 + 64 * (wc - 2) + nat;
}
#define STAGE 4
namespace pg8 {
#define PG8_LAS __attribute__((address_space(3)))
typedef unsigned short bf16_t;
typedef short bf16x8 __attribute__((ext_vector_type(8)));
typedef float f32x4 __attribute__((ext_vector_type(4)));
typedef unsigned u32x4 __attribute__((ext_vector_type(4)));
constexpr int BM = 256, BK = 64, HALF = 128, HTB = HALF * BK * 2  , STAGE_BYTES = 8 * HTB, NXCD = 8, WGM = 8;

__host__ __device__ __forceinline__ int lds_byte(int r, int c) { const int st = (r >> 4) * 2 + (c >> 5), rr = r & 15, cc = c & 31, ob = rr * 64 + cc * 2; return st * 1024 + (ob ^ (((ob >> 9) & 1) << 5)); }
__host__ __device__ __forceinline__ void stage_rc(int b, int& R, int& C) { const int st = b / 1024, sb = b % 1024, swz = sb ^ (((sb >> 9) & 1) << 5); R = (st >> 1) * 16 + swz / 64; C = (st & 1) * 32 + (swz % 64) / 2; }
__host__ __device__ __forceinline__ int perm32(int rho) { const int n = rho >> 4, i = rho & 15; return 8 * (i >> 2) + 4 * n + (i & 3); }

struct Unit { int pm, pn; };
struct Gemm { const bf16_t* A; const bf16_t* Bt; int M, N, K; };

struct StaticOrder {
    int nM, nN, nwg, G, c;
    __host__ __device__ void init(int M, int N, int G_, int c_) { nM = M / BM; nN = N / BM; nwg = nM * nN; G = G_; c = c_; }
    __host__ __device__ bool next(int i, Unit& u) const {
        const long L = (long)i * G + c; if (L >= nwg) return false;
        int wgid = (int)L; { const int q = nwg / NXCD, r = nwg % NXCD, xcd = wgid % NXCD, off = wgid / NXCD; wgid = (xcd < r ? xcd * (q + 1) : r * (q + 1) + (xcd - r) * q) + off; }
        const int nig = WGM * nN, gid = wgid / nig, fm = gid * WGM, gsz = (nM - fm) < WGM ? (nM - fm) : WGM;
        u.pm = fm + ((wgid % nig) % gsz); u.pn = (wgid % nig) / gsz; return true;
    }
    __device__ __forceinline__ void a_ready(const Unit&) const {}
    __device__ __forceinline__ void done(const Unit&) const {}
};


__device__ __forceinline__ unsigned cvt_pk_bf16(float lo, float hi) { unsigned r; asm volatile("v_cvt_pk_bf16_f32 %0, %1, %2" : "=v"(r) : "v"(lo), "v"(hi)); return r; }
__device__ __forceinline__ u32x4 pack8(const f32x4& a, const f32x4& b) { u32x4 w; w.x = cvt_pk_bf16(a[0], a[1]); w.y = cvt_pk_bf16(a[2], a[3]); w.z = cvt_pk_bf16(b[0], b[1]); w.w = cvt_pk_bf16(b[2], b[3]); return w; }
__device__ __forceinline__ float silu_f(float g) { return g * __builtin_amdgcn_rcpf(1.0f + __expf(-g)); }

struct EpiG1 {
    static constexpr bool PERM = true, AFTER_DRAIN = false;
    bf16_t *qa, *ka, *va, *qb, *kb, *vb, *mix; const float* tab1; const float* tab2; const float *qn, *kn;
    __device__ __forceinline__ void operator()(const f32x4 (&acc)[2][2][4][2], const Unit& u, int wr, int wc, int fr, int fq) const {
        const int pn = u.pn, m0 = u.pm * BM, t0 = m0 < MP ? (m0 & 4095) : ((m0 - MP) & 2047);
        int mode, pitch; bf16_t* dst; float sc = 1.f; const float* gn = nullptr;
        if (pn < 2)       { mode = 0; dst = qa + (4 * pn + wc) * 64; pitch = 512; sc = C2; }
        else if (pn < 4)  { mode = 0; dst = ka + (4 * (pn - 2) + wc) * 64; pitch = 512; }
        else if (pn < 6)  { mode = 1; dst = va + (4 * (pn - 4) + wc) * 64; pitch = 512; }
        else if (pn < 8)  { mode = 2; dst = mix + (4 * (pn - 6) + wc) * 64; pitch = 1024; }
        else if (pn < 10) { mode = 3; dst = qb + (4 * (pn - 8) + wc) * 64; pitch = 512; sc = C2; gn = qn; }
        else if (pn < 12) { mode = 2; dst = mix + 512 + (4 * (pn - 10) + wc) * 64; pitch = 1024; }
        else if (wc < 2)  { mode = 3; dst = kb + wc * 64; pitch = 128; gn = kn; }
        else              { mode = 1; dst = vb + (wc - 2) * 64; pitch = 128; }
        const int rloc = wr * 64 + fr;
        if (mode == 0) {
#pragma unroll
            for (int ai = 0; ai < 2; ++ai)
#pragma unroll
                for (int m = 0; m < 4; ++m) { const int rl = rloc + ai * HALF + m * 16; const float* tp = tab1 + ((size_t)(t0 + rl) * 32 + 8 * fq) * 2;
                    const f32x4 c0 = *(const f32x4*)tp, c1 = *(const f32x4*)(tp + 4), c2 = *(const f32x4*)(tp + 8), c3 = *(const f32x4*)(tp + 12);
                    const f32x4 a0 = acc[ai][0][m][0], a1 = acc[ai][0][m][1], b0 = acc[ai][1][m][0], b1 = acc[ai][1][m][1];
                    f32x4 o10, o11, o20, o21;
                    o10[0] = (a0[0] * c0[0] - b0[0] * c0[1]) * sc; o20[0] = (b0[0] * c0[0] + a0[0] * c0[1]) * sc;
                    o10[1] = (a0[1] * c0[2] - b0[1] * c0[3]) * sc; o20[1] = (b0[1] * c0[2] + a0[1] * c0[3]) * sc;
                    o10[2] = (a0[2] * c1[0] - b0[2] * c1[1]) * sc; o20[2] = (b0[2] * c1[0] + a0[2] * c1[1]) * sc;
                    o10[3] = (a0[3] * c1[2] - b0[3] * c1[3]) * sc; o20[3] = (b0[3] * c1[2] + a0[3] * c1[3]) * sc;
                    o11[0] = (a1[0] * c2[0] - b1[0] * c2[1]) * sc; o21[0] = (b1[0] * c2[0] + a1[0] * c2[1]) * sc;
                    o11[1] = (a1[1] * c2[2] - b1[1] * c2[3]) * sc; o21[1] = (b1[1] * c2[2] + a1[1] * c2[3]) * sc;
                    o11[2] = (a1[2] * c3[0] - b1[2] * c3[1]) * sc; o21[2] = (b1[2] * c3[0] + a1[2] * c3[1]) * sc;
                    o11[3] = (a1[3] * c3[2] - b1[3] * c3[3]) * sc; o21[3] = (b1[3] * c3[2] + a1[3] * c3[3]) * sc;
                    bf16_t* rowp = dst + (size_t)(m0 + rl) * pitch + 8 * fq;
                    *(u32x4*)rowp = pack8(o10, o11); *(u32x4*)(rowp + 32) = pack8(o20, o21); }
        } else if (mode == 1 || mode == 2) {
#pragma unroll
            for (int ai = 0; ai < 2; ++ai)
#pragma unroll
                for (int m = 0; m < 4; ++m) { const int rl = rloc + ai * HALF + m * 16;
                    f32x4 a0 = acc[ai][0][m][0], a1 = acc[ai][0][m][1], b0 = acc[ai][1][m][0], b1 = acc[ai][1][m][1];
                    if (mode == 2) {
#pragma unroll
                        for (int j = 0; j < 4; ++j) { a0[j] = silu_f(a0[j]); a1[j] = silu_f(a1[j]); b0[j] = silu_f(b0[j]); b1[j] = silu_f(b1[j]); } }
                    bf16_t* rowp = dst + (size_t)(m0 + rl) * pitch + 8 * fq;
                    *(u32x4*)rowp = pack8(a0, a1); *(u32x4*)(rowp + 32) = pack8(b0, b1); }
        } else {
            const int d1b = fq < 2 ? 8 * fq : 32 + 8 * (fq - 2);
            const f32x4 g10 = *(const f32x4*)(gn + d1b), g11 = *(const f32x4*)(gn + d1b + 4), g20 = *(const f32x4*)(gn + d1b + 16), g21 = *(const f32x4*)(gn + d1b + 20);
#pragma unroll
            for (int ai = 0; ai < 2; ++ai)
#pragma unroll
                for (int m = 0; m < 4; ++m) { const int rl = rloc + ai * HALF + m * 16, t = t0 + rl;
                    f32x4 a0 = acc[ai][0][m][0], a1 = acc[ai][0][m][1], b0 = acc[ai][1][m][0], b1 = acc[ai][1][m][1];
                    float ss = 0.f;
#pragma unroll
                    for (int j = 0; j < 4; ++j) ss += (a0[j] * a0[j] + a1[j] * a1[j]) + (b0[j] * b0[j] + b1[j] * b1[j]);
                    ss += __shfl_xor(ss, 16); ss += __shfl_xor(ss, 32);
                    const float rs = (1.0f / sqrtf(ss * (1.f / 64.f) + RMS_EPS));
                    a0 = a0 * g10 * rs; a1 = a1 * g11 * rs; b0 = b0 * g20 * rs; b1 = b1 * g21 * rs;
                    const int pos = fq < 2 ? (t >> 6) : (t & 63); const float* tp = tab2 + ((size_t)pos * 16 + 8 * (fq & 1)) * 2;
                    const f32x4 c0 = *(const f32x4*)tp, c1 = *(const f32x4*)(tp + 4), c2 = *(const f32x4*)(tp + 8), c3 = *(const f32x4*)(tp + 12);
                    f32x4 o10, o11, o20, o21;
                    o10[0] = (a0[0] * c0[0] - b0[0] * c0[1]) * sc; o20[0] = (b0[0] * c0[0] + a0[0] * c0[1]) * sc;
                    o10[1] = (a0[1] * c0[2] - b0[1] * c0[3]) * sc; o20[1] = (b0[1] * c0[2] + a0[1] * c0[3]) * sc;
                    o10[2] = (a0[2] * c1[0] - b0[2] * c1[1]) * sc; o20[2] = (b0[2] * c1[0] + a0[2] * c1[1]) * sc;
                    o10[3] = (a0[3] * c1[2] - b0[3] * c1[3]) * sc; o20[3] = (b0[3] * c1[2] + a0[3] * c1[3]) * sc;
                    o11[0] = (a1[0] * c2[0] - b1[0] * c2[1]) * sc; o21[0] = (b1[0] * c2[0] + a1[0] * c2[1]) * sc;
                    o11[1] = (a1[1] * c2[2] - b1[1] * c2[3]) * sc; o21[1] = (b1[1] * c2[2] + a1[1] * c2[3]) * sc;
                    o11[2] = (a1[2] * c3[0] - b1[2] * c3[1]) * sc; o21[2] = (b1[2] * c3[0] + a1[2] * c3[1]) * sc;
                    o11[3] = (a1[3] * c3[2] - b1[3] * c3[3]) * sc; o21[3] = (b1[3] * c3[2] + a1[3] * c3[3]) * sc;
                    bf16_t* rowp = dst + (size_t)(m0 + rl) * pitch + d1b;
                    *(u32x4*)rowp = pack8(o10, o11); *(u32x4*)(rowp + 16) = pack8(o20, o21); }
        }
    }
};
struct EpiPre {
    static constexpr bool PERM = false, AFTER_DRAIN = false;
    const float* xp; const float* xs; float* out;
    __device__ __forceinline__ void operator()(const f32x4 (&acc)[2][2][4][2], const Unit& u, int wr, int wc, int fr, int fq) const {
        const int m0 = u.pm * BM; const float* xb = m0 < MP ? xp + (size_t)m0 * DM : xs + (size_t)(m0 - MP) * DM; float* ob = out + (size_t)m0 * DM;
        const int col0 = u.pn * BM + wc * 32 + 4 * fq;
#pragma unroll
        for (int ai = 0; ai < 2; ++ai)
#pragma unroll
            for (int m = 0; m < 4; ++m) { const size_t off = (size_t)(ai * HALF + wr * 64 + m * 16 + fr) * DM + col0;
#pragma unroll
                for (int bj = 0; bj < 2; ++bj)
#pragma unroll
                    for (int n = 0; n < 2; ++n) { const f32x4 xv = *(const f32x4*)(xb + off + bj * HALF + n * 16); *(f32x4*)(ob + off + bj * HALF + n * 16) = xv * ALPHA + acc[ai][bj][m][n]; } }
    }
};
template <class Epi, class Sched, bool ALIGN_EPI = false, bool SP2 = false>
__device__ __forceinline__ void gemm_phase(PG8_LAS unsigned char* lds, const Gemm g, const Sched& S, const Epi& E) {
    const int tid = threadIdx.x, wid = __builtin_amdgcn_readfirstlane(tid >> 6), lane = tid & 63, wr = wid >> 2, wc = wid & 3, fr = lane & 15, fq = lane >> 4;
    const int K = g.K, nt = K / BK;
    unsigned voffA[2], voffB[2];
#pragma unroll
    for (int i = 0; i < 2; ++i) { int R, C; stage_rc(tid * 16 + i * 8192, R, C); const int Rb = Epi::PERM ? ((R & ~31) + perm32(R & 31)) : R;
        voffA[i] = (unsigned)(R * K + C) * 2u; voffB[i] = (unsigned)(Rb * K + C) * 2u; }
    const size_t kstep = (size_t)(BK * 2);
    const size_t hstep = (size_t)HALF * K * 2;
    const size_t tstep = 2 * hstep;
    const unsigned ldsw = (unsigned)wid * 1024u;
    const int aoff = lds_byte(wr * 64 + fr, fq * 8), boff = lds_byte(wc * 32 + fr, fq * 8);
#define PG8_SA(b, h) (((b) * 2 + (h)) * HTB)
#define PG8_SB(b, h) ((4 + (b) * 2 + (h)) * HTB)
#define PG8_STAGE(bufoff, gbase, voff) do { _Pragma("unroll") for (int _i = 0; _i < 2; ++_i) \
        __builtin_amdgcn_global_load_lds((const unsigned*)((const char*)(gbase) + (voff)[_i]), (PG8_LAS unsigned*)(lds + (bufoff) + ldsw + _i * 8192), 16, 0, 0); } while (0)
#define PG8_LDA(dst, b, h) do { _Pragma("unroll") for (int m = 0; m < 4; ++m) _Pragma("unroll") for (int k = 0; k < 2; ++k) dst[m][k] = *(const PG8_LAS bf16x8*)(lds + PG8_SA(b, h) + aoff + m * 2048 + k * 1024); } while (0)
#define PG8_LDB(dst, b, h) do { _Pragma("unroll") for (int n = 0; n < 2; ++n) _Pragma("unroll") for (int k = 0; k < 2; ++k) dst[n][k] = *(const PG8_LAS bf16x8*)(lds + PG8_SB(b, h) + boff + n * 2048 + k * 1024); } while (0)
#define PG8_MMA(ai, bj, At, Bt) do { __builtin_amdgcn_s_setprio(1); _Pragma("unroll") for (int m = 0; m < 4; ++m) _Pragma("unroll") for (int n = 0; n < 2; ++n) _Pragma("unroll") for (int k = 0; k < 2; ++k) \
        acc[ai][bj][m][n] = __builtin_amdgcn_mfma_f32_16x16x32_bf16(Bt[n][k], At[m][k], acc[ai][bj][m][n], 0, 0, 0); __builtin_amdgcn_s_setprio(0); } while (0)
#define PG8_WAIT_V(n) asm volatile("s_waitcnt vmcnt(" #n ")" ::: "memory")
#define PG8_WAIT_L(n) asm volatile("s_waitcnt lgkmcnt(" #n ")" ::: "memory")
#define PG8_BAR __builtin_amdgcn_s_barrier()
#define PG8_SCHED __builtin_amdgcn_sched_barrier(0)
    Unit cur, nxt; int ui = 0;
    if (!S.next(0, cur)) return;
    f32x4 acc[2][2][4][2];
#pragma unroll
    for (int a = 0; a < 2; ++a)
#pragma unroll
        for (int b = 0; b < 2; ++b)
#pragma unroll
            for (int m = 0; m < 4; ++m)
#pragma unroll
                for (int n = 0; n < 2; ++n) acc[a][b][m][n] = (f32x4){0.f, 0.f, 0.f, 0.f};
    bf16x8 At[4][2], B0[2][2], B1[2][2];
    const char* cA = (const char*)g.A + (size_t)cur.pm * tstep; const char* cB = (const char*)g.Bt + (size_t)cur.pn * tstep;
    S.a_ready(cur);
    if constexpr (SP2) {
        PG8_STAGE(PG8_SB(0, 0), cB, voffB); PG8_STAGE(PG8_SB(0, 1), cB + hstep, voffB); PG8_STAGE(PG8_SA(0, 0), cA, voffA); PG8_STAGE(PG8_SA(0, 1), cA + hstep, voffA);
        if (wr == 1) PG8_BAR;
        PG8_WAIT_V(2); PG8_BAR;
        PG8_STAGE(PG8_SB(1, 0), cB + kstep, voffB); PG8_STAGE(PG8_SA(1, 0), cA + kstep, voffA); PG8_STAGE(PG8_SB(1, 1), cB + hstep + kstep, voffB);
        PG8_WAIT_V(6); PG8_BAR;
    } else {
        PG8_STAGE(PG8_SB(0, 0), cB, voffB); PG8_STAGE(PG8_SA(0, 0), cA, voffA); PG8_STAGE(PG8_SB(0, 1), cB + hstep, voffB); PG8_STAGE(PG8_SA(0, 1), cA + hstep, voffA);
        if (wr == 1) PG8_BAR;
        PG8_WAIT_V(4); PG8_BAR;
        PG8_STAGE(PG8_SB(1, 0), cB + kstep, voffB); PG8_STAGE(PG8_SA(1, 0), cA + kstep, voffA); PG8_STAGE(PG8_SB(1, 1), cB + hstep + kstep, voffB);
        PG8_WAIT_V(6); PG8_BAR;
    }
    for (;;) {
        const bool has_next = S.next(ui + 1, nxt);
        const char* nA = has_next ? (const char*)g.A + (size_t)nxt.pm * tstep : cA; const char* nB = has_next ? (const char*)g.Bt + (size_t)nxt.pn * tstep : cB;
        for (int t = 0; t < nt; t += 2) {
            const bool last = (t == nt - 2);
            const char* a1 = cA + (size_t)(t + 1) * kstep;
            const char* a2 = last ? nA : cA + (size_t)(t + 2) * kstep; const char* b2 = last ? nB : cB + (size_t)(t + 2) * kstep;
            const char* a3 = a2 + kstep; const char* b3 = b2 + kstep;
            if (last && has_next) S.a_ready(nxt);
            if constexpr (SP2) {
            PG8_LDB(B0, 0, 0); PG8_LDB(B1, 0, 1); PG8_SCHED; PG8_LDA(At, 0, 0); PG8_STAGE(PG8_SA(1, 1), a1 + hstep, voffA);
            PG8_WAIT_V(8); PG8_WAIT_L(0); PG8_BAR; PG8_MMA(0, 0, At, B0); PG8_MMA(0, 1, At, B1); PG8_BAR; PG8_SCHED;
            PG8_LDA(At, 0, 1); PG8_STAGE(PG8_SB(0, 0), b2, voffB); PG8_STAGE(PG8_SB(0, 1), b2 + hstep, voffB); PG8_STAGE(PG8_SA(0, 0), a2, voffA);
            PG8_WAIT_V(8); PG8_WAIT_L(0); PG8_BAR; PG8_MMA(1, 0, At, B0); PG8_MMA(1, 1, At, B1); PG8_BAR; PG8_SCHED;
            PG8_LDB(B0, 1, 0); PG8_LDB(B1, 1, 1); PG8_SCHED; PG8_LDA(At, 1, 0); PG8_STAGE(PG8_SA(0, 1), a2 + hstep, voffA);
            PG8_WAIT_V(8); PG8_WAIT_L(0); PG8_BAR; PG8_MMA(0, 0, At, B0); PG8_MMA(0, 1, At, B1); PG8_BAR; PG8_SCHED;
            PG8_LDA(At, 1, 1); PG8_STAGE(PG8_SB(1, 0), b3, voffB); PG8_STAGE(PG8_SB(1, 1), b3 + hstep, voffB); PG8_STAGE(PG8_SA(1, 0), a3, voffA);
            PG8_WAIT_V(8); PG8_WAIT_L(0); PG8_BAR; PG8_MMA(1, 0, At, B0); PG8_MMA(1, 1, At, B1); PG8_BAR; PG8_SCHED;
            } else {
            PG8_LDB(B0, 0, 0); PG8_SCHED; PG8_LDA(At, 0, 0); PG8_STAGE(PG8_SA(1, 1), a1 + hstep, voffA);
            PG8_WAIT_L(8); PG8_BAR; PG8_WAIT_L(0); PG8_MMA(0, 0, At, B0); PG8_BAR; PG8_SCHED;
            PG8_LDB(B1, 0, 1); PG8_STAGE(PG8_SB(0, 0), b2, voffB);
            PG8_BAR; PG8_WAIT_L(0); PG8_MMA(0, 1, At, B1); PG8_BAR;
            PG8_LDA(At, 0, 1); PG8_STAGE(PG8_SA(0, 0), a2, voffA);
            PG8_BAR; PG8_WAIT_L(0); PG8_MMA(1, 0, At, B0); PG8_BAR; PG8_SCHED;
            PG8_STAGE(PG8_SB(0, 1), b2 + hstep, voffB);
            PG8_WAIT_V(6); PG8_BAR; PG8_MMA(1, 1, At, B1); PG8_BAR;
            PG8_LDB(B0, 1, 0); PG8_SCHED; PG8_LDA(At, 1, 0); PG8_STAGE(PG8_SA(0, 1), a2 + hstep, voffA);
            PG8_WAIT_L(8); PG8_BAR; PG8_WAIT_L(0); PG8_MMA(0, 0, At, B0); PG8_BAR; PG8_SCHED;
            PG8_LDB(B1, 1, 1); PG8_STAGE(PG8_SB(1, 0), b3, voffB);
            PG8_BAR; PG8_WAIT_L(0); PG8_MMA(0, 1, At, B1); PG8_BAR;
            PG8_LDA(At, 1, 1); PG8_STAGE(PG8_SA(1, 0), a3, voffA);
            PG8_BAR; PG8_WAIT_L(0); PG8_MMA(1, 0, At, B0); PG8_BAR; PG8_SCHED;
            PG8_STAGE(PG8_SB(1, 1), b3 + hstep, voffB);
            PG8_WAIT_V(6); PG8_BAR; PG8_MMA(1, 1, At, B1); PG8_BAR;
            }
        }
        if constexpr (ALIGN_EPI) { if (wr == 0) PG8_BAR; }
        if constexpr (!Epi::AFTER_DRAIN) { E(acc, cur, wr, wc, fr, fq); S.done(cur); }
        if (!has_next) break;
#pragma unroll
        for (int a = 0; a < 2; ++a)
#pragma unroll
            for (int b = 0; b < 2; ++b)
#pragma unroll
                for (int m = 0; m < 4; ++m)
#pragma unroll
                    for (int n = 0; n < 2; ++n) acc[a][b][m][n] = (f32x4){0.f, 0.f, 0.f, 0.f};
        cur = nxt; cA = nA; cB = nB; ++ui;
        if constexpr (ALIGN_EPI) { if (wr == 1) PG8_BAR; }
    }
    PG8_WAIT_V(0);
    if constexpr (!ALIGN_EPI) { if (wr == 0) PG8_BAR; }
    PG8_BAR;
    if constexpr (Epi::AFTER_DRAIN) { E.fused(acc, cur, wr, wc, fr, fq, lds, wid, lane); S.done(cur); }
#undef PG8_SA
#undef PG8_SB
#undef PG8_STAGE
#undef PG8_LDA
#undef PG8_LDB
#undef PG8_MMA
#undef PG8_WAIT_V
#undef PG8_WAIT_L
#undef PG8_BAR
#undef PG8_SCHED
}
}
namespace attn_body {
using bf16=__hip_bfloat16;
using bf16x8=__attribute__((ext_vector_type(8)))short;
using s16x4=__attribute__((ext_vector_type(4)))short;
using f32x16=__attribute__((ext_vector_type(16)))float;
using u32x4=__attribute__((ext_vector_type(4)))unsigned;
constexpr int D=64,QP=512,KP=128,OP=1024;
constexpr int NW=8,QBLK=32,QB=QBLK*NW,KVBLK=64;
__device__ __forceinline__ int crow(int r,int hi){return (r&3)+8*(r>>2)+4*hi;}
#define SBAR() __builtin_amdgcn_sched_barrier(0)
constexpr int NSLOT=3, SLOTB=8192;
constexpr int LDS_K=0, LDS_V=NSLOT*SLOTB, LDS_WS=2*NSLOT*SLOTB, LDS_OST=LDS_WS+NW*64*4, LDS_BYTES=LDS_OST+NW*4096;
constexpr float C2=0.125f*1.4426950408889634f;
__device__ __forceinline__ void glds16(const void*gsrc,unsigned lds_dst){unsigned keep;
  asm volatile("s_mov_b32 %0, m0\n\ts_mov_b32 m0, %2\n\ts_nop 0\n\tglobal_load_lds_dwordx4 %1, off\n\ts_mov_b32 m0, %0":"=&s"(keep):"v"(gsrc),"s"(lds_dst):"memory");}
__device__ __forceinline__ float max3f(float a,float b,float c){float r;asm("v_max3_f32 %0, %1, %2, %3":"=v"(r):"v"(a),"v"(b),"v"(c));return r;}
__device__ __forceinline__ float max2f(float a,float b){float r;asm("v_max_f32_e32 %0, %1, %2":"=v"(r):"v"(a),"v"(b));return r;}
__device__ __forceinline__ float fadd_s(float a,float b){float r;asm("v_add_f32_e32 %0, %1, %2":"=v"(r):"v"(a),"v"(b));return r;}
__device__ __forceinline__ float fsub_s(float a,float b){float r;asm("v_sub_f32_e32 %0, %1, %2":"=v"(r):"v"(a),"v"(b));return r;}
typedef float f32x2_t __attribute__((ext_vector_type(2))); typedef __bf16 bf16x2_t __attribute__((ext_vector_type(2)));
__device__ __forceinline__ unsigned cvtpk_s(float lo,float hi){f32x2_t v={lo,hi};bf16x2_t b=__builtin_convertvector(v,bf16x2_t);return __builtin_bit_cast(unsigned,b);}
#define WAIT_BAR(N) asm volatile("s_waitcnt vmcnt(" #N ") lgkmcnt(0)\n\ts_barrier":::"memory")

__device__ __forceinline__ void qkt(f32x16&p0,f32x16&p1,const char*Kslot,const bf16x8*qr,const f32x16&negm,int r32,int hi){
  const char*kb=Kslot+hi*1024+r32*16;
  #pragma unroll
  for(int d0=0;d0<4;++d0){
    const bf16x8 b0=*reinterpret_cast<const bf16x8*>(kb+d0*2048);
    const bf16x8 b1=*reinterpret_cast<const bf16x8*>(kb+d0*2048+512);
    if(d0==0){p0=__builtin_amdgcn_mfma_f32_32x32x16_bf16(b0,qr[0],negm,0,0,0);p1=__builtin_amdgcn_mfma_f32_32x32x16_bf16(b1,qr[0],negm,0,0,0);}
    else{p0=__builtin_amdgcn_mfma_f32_32x32x16_bf16(b0,qr[d0],p0,0,0,0);p1=__builtin_amdgcn_mfma_f32_32x32x16_bf16(b1,qr[d0],p1,0,0,0);}}
}
typedef __attribute__((address_space(3))) const char* lds_cptr;
typedef short v4i16_t __attribute__((ext_vector_type(4)));
__device__ __forceinline__ void kload8(bf16x8*kf,lds_cptr kp){
  kf[0]=*(const __attribute__((address_space(3))) bf16x8*)(kp);      kf[1]=*(const __attribute__((address_space(3))) bf16x8*)(kp+512);
  kf[2]=*(const __attribute__((address_space(3))) bf16x8*)(kp+2048); kf[3]=*(const __attribute__((address_space(3))) bf16x8*)(kp+2560);
  kf[4]=*(const __attribute__((address_space(3))) bf16x8*)(kp+4096); kf[5]=*(const __attribute__((address_space(3))) bf16x8*)(kp+4608);
  kf[6]=*(const __attribute__((address_space(3))) bf16x8*)(kp+6144); kf[7]=*(const __attribute__((address_space(3))) bf16x8*)(kp+6656);
}
__device__ __forceinline__ void kload2(bf16x8*kf,lds_cptr kp,int j){ kf[2*j]=*(const __attribute__((address_space(3))) bf16x8*)(kp+j*2048); kf[2*j+1]=*(const __attribute__((address_space(3))) bf16x8*)(kp+j*2048+512); }
__device__ __forceinline__ s16x4 vtr(lds_cptr p){ return __builtin_bit_cast(s16x4,__builtin_amdgcn_ds_read_tr16_b64_v4i16((__attribute__((address_space(3))) v4i16_t*)p)); }
__device__ __forceinline__ float rowmax(const f32x16&p0,const f32x16&p1){
  float a=max3f(p0[0],p0[1],p1[0]),b=max3f(p0[2],p0[3],p1[1]);a=max3f(a,p1[2],p1[3]);
  #pragma unroll
  for(int r=4;r<16;r+=4){a=max3f(a,p0[r],p0[r+1]);b=max3f(b,p0[r+2],p0[r+3]);a=max3f(a,p1[r],p1[r+1]);b=max3f(b,p1[r+2],p1[r+3]);}
  const float m=max2f(a,b);
  auto rr=__builtin_amdgcn_permlane32_swap(__float_as_uint(m),__float_as_uint(m),false,false);
  return max2f(__uint_as_float(rr[0]),__uint_as_float(rr[1]));
}
__device__ __forceinline__ void pv(f32x16*o,int vb,bf16x8 pa0,bf16x8 pa1,bf16x8 pa2,bf16x8 pa3){
  #pragma unroll
  for(int d0=0;d0<2;++d0){s16x4 lo[4],hi[4];
    #pragma unroll
    for(int ks=0;ks<4;++ks){
      asm volatile("ds_read_b64_tr_b16 %0,%1 offset:%c2":"=&v"(lo[ks]):"v"(vb),"i"(d0*4096+ks*1024):"memory");
      asm volatile("ds_read_b64_tr_b16 %0,%1 offset:%c2":"=&v"(hi[ks]):"v"(vb),"i"(d0*4096+ks*1024+512):"memory");}
    asm volatile("s_waitcnt lgkmcnt(0)":::"memory");SBAR();
    #define PK(k) (bf16x8){lo[k][0],lo[k][1],lo[k][2],lo[k][3],hi[k][0],hi[k][1],hi[k][2],hi[k][3]}
    o[d0]=__builtin_amdgcn_mfma_f32_32x32x16_bf16(pa0,PK(0),o[d0],0,0,0);
    o[d0]=__builtin_amdgcn_mfma_f32_32x32x16_bf16(pa1,PK(1),o[d0],0,0,0);
    o[d0]=__builtin_amdgcn_mfma_f32_32x32x16_bf16(pa2,PK(2),o[d0],0,0,0);
    o[d0]=__builtin_amdgcn_mfma_f32_32x32x16_bf16(pa3,PK(3),o[d0],0,0,0);
    #undef PK
  }
}

#ifndef ATTN_STORE16
#define ATTN_STORE16(p,v) (*(u32x4*)(p)=(v))
#endif
template<int THRL> __device__ __forceinline__ void attn_unit(long rowbase,int SEQ,int h,int qb,const bf16*Q,const bf16*__restrict__ K,const bf16*__restrict__ V,bf16*O,char*shm){
  const int tid=threadIdx.x,lane=tid&63,r32=lane&31,hi=lane>>5; const int wid=__builtin_amdgcn_readfirstlane(tid>>6);
  const int q0=qb*QB;
  const bf16*Qw=Q+(rowbase+q0+wid*QBLK)*QP+h*D;
  const bf16*Kh=K+rowbase*KP+(h>>2)*D,*Vh=V+rowbase*KP+(h>>2)*D;
  const unsigned lds0=(unsigned)(uintptr_t)shm;
  float*wsf=(float*)(shm+LDS_WS)+wid*64;
  const bf16*ksrc=Kh+(long)lane*KP+wid*8;
  const bf16*vsrc=Vh+(long)(16*(wid&3)+(lane>>2))*KP+(wid>>2)*32+(lane&3)*8;
  const unsigned kdst=lds0+LDS_K+wid*1024, vdst=lds0+LDS_V+wid*1024;
  #define DMA_K(t,slot) glds16(ksrc+(long)(t)*KVBLK*KP,(unsigned)__builtin_amdgcn_readfirstlane(kdst+(slot)))
  #define DMA_V(t,slot) glds16(vsrc+(long)(t)*KVBLK*KP,(unsigned)__builtin_amdgcn_readfirstlane(vdst+(slot)))
  const int vb0=(int)(lds0+LDS_V)+((lane>>4)&1)*32+(lane&3)*8+(4*hi+((lane&15)>>2))*64;
  const char*Kbase=shm+LDS_K; bf16x8 kf[8];
  const lds_cptr shm3=(lds_cptr)shm; const lds_cptr kp0=shm3+LDS_K+hi*1024+r32*16; const lds_cptr vp0=shm3+LDS_V+((lane>>4)&1)*32+(lane&3)*8+(4*hi+((lane&15)>>2))*64;
  const int NT=SEQ/KVBLK;
  DMA_K(0,0);DMA_V(0,0);DMA_K(1,SLOTB);
  bf16x8 qr[4];
  #pragma unroll
  for(int d0=0;d0<4;++d0)qr[d0]=*reinterpret_cast<const bf16x8*>(&Qw[(long)r32*QP+d0*16+hi*8]);
  float mhat=0.f,l_reg=0.f;f32x16 o[2];o[0]=f32x16{};o[1]=f32x16{};f32x16 negm=f32x16{};asm volatile("":"+v"(negm));
  #define CMASK(P0,P1,t) do{}while(0)
  bool resc=false;
  #define START(P0,P1) do{ const float rm=rowmax(P0,P1); resc=false; \
    { const float dl=rm; mhat=fadd_s(mhat,dl); \
      _Pragma("unroll") for(int r=0;r<16;++r){P0[r]=fsub_s(P0[r],dl);P1[r]=fsub_s(P1[r],dl);} \
      _Pragma("unroll") for(int r=0;r<16;++r)negm[r]=-mhat; asm volatile("":"+v"(negm)); } \
    _Pragma("unroll") for(int r=0;r<16;++r)P0[r]=__builtin_amdgcn_exp2f(P0[r]); }while(0)
  #define RESC() do{ if(resc){ asm volatile("s_waitcnt lgkmcnt(0)":::"memory"); \
      _Pragma("unroll") for(int d_=0;d_<2;++d_) _Pragma("unroll") for(int r=0;r<16;++r)o[d_][r]*=wsf[crow(r,hi)]; } }while(0)
  f32x16 pA0,pA1,pB0,pB1;
  int sl_prev=0,sl_cur=0,sl_next=SLOTB;
  #define ROT() do{sl_prev=sl_cur;sl_cur=sl_next;sl_next=(sl_next==(NSLOT-1)*SLOTB)?0:sl_next+SLOTB;}while(0)
  DMA_K(2,2*SLOTB);
  WAIT_BAR(3);
  qkt(pA0,pA1,Kbase,qr,negm,r32,hi);asm volatile("s_nop 15\n\ts_nop 7":"+v"(pA0),"+v"(pA1));CMASK(pA0,pA1,0);
  START(pA0,pA1);
  _Pragma("unroll") for(int r=0;r<16;++r)pA1[r]=__builtin_amdgcn_exp2f(pA1[r]);
  WAIT_BAR(0);
  DMA_K(3,0);DMA_V(1,SLOTB);
  ROT();
  kload8(kf,kp0+sl_cur);
  WAIT_BAR(2);
  s16x4 vlo[8],vhi[8]; u32x4 pw0,pw1,pw2,pw3;
  #define PKW(P,B) cvtpk_s(P[B],P[B+1])
  #define PAF(k) __builtin_bit_cast(bf16x8,pw##k)
  #define VFR(i) (bf16x8){vlo[i][0],vlo[i][1],vlo[i][2],vlo[i][3],vhi[i][0],vhi[i][1],vhi[i][2],vhi[i][3]}
  #define PIN(x) asm volatile("":"+v"(x))
  #define MX3(a,b,c) __builtin_fmaxf(__builtin_fmaxf((a),(b)),(c))
  #define GAPA(MF,A0,A1,A2,A3,W0,W1,PW) do{ MF; sacc+=A0; sacc+=A1; sacc+=A2; sacc+=A3; PIN(sacc); W0; W1; PIN(PW); SBAR(); }while(0)
  #define EX(v) __builtin_amdgcn_exp2f(v)
  #define GAPB(MF,X,B) do{ MF; X[B]=EX(X[B]); X[B+1]=EX(X[B+1]); X[B+2]=EX(X[B+2]); X[B+3]=EX(X[B+3]); PIN(X); SBAR(); }while(0)
  #define VRD(i) do{ vlo[i]=vtr(vp_+(((i)>>2)*4096+((i)&3)*1024)); vhi[i]=vtr(vp_+(((i)>>2)*4096+((i)&3)*1024+512)); }while(0)
  #define KRD(G,j) do{ if(G){ kload2(kf,kp0+sl_next,j); SBAR(); } }while(0)
  #define STEP(C0,C1,P0,P1,t,GK,GV,GL) do{ SBAR(); \
    const lds_cptr vp_=vp0+sl_prev; \
    VRD(0); SBAR(); float sacc=(P0[0]+P0[1]); \
    GAPA(C0=__builtin_amdgcn_mfma_f32_32x32x16_bf16(kf[0],qr[0],negm,0,0,0), P0[2],P0[3],P0[4],P0[5],     pw0[0]=PKW(P0,0), pw0[1]=PKW(P0,2), pw0); \
    VRD(4); SBAR(); GAPA(C1=__builtin_amdgcn_mfma_f32_32x32x16_bf16(kf[1],qr[0],negm,0,0,0), P0[6],P0[7],P0[8],P0[9],     pw0[2]=PKW(P0,4), pw0[3]=PKW(P0,6), pw0); \
    VRD(1); SBAR(); GAPA(C0=__builtin_amdgcn_mfma_f32_32x32x16_bf16(kf[2],qr[1],C0,0,0,0),   P0[10],P0[11],P0[12],P0[13], pw1[0]=PKW(P0,8), pw1[1]=PKW(P0,10), pw1); \
    VRD(5); SBAR(); GAPA(C1=__builtin_amdgcn_mfma_f32_32x32x16_bf16(kf[3],qr[1],C1,0,0,0),   P0[14],P0[15],P1[0],P1[1],   pw1[2]=PKW(P0,12),pw1[3]=PKW(P0,14), pw1); \
    VRD(2); SBAR(); GAPA(C0=__builtin_amdgcn_mfma_f32_32x32x16_bf16(kf[4],qr[2],C0,0,0,0),   P1[2],P1[3],P1[4],P1[5],     pw2[0]=PKW(P1,0), pw2[1]=PKW(P1,2), pw2); \
    VRD(6); SBAR(); GAPA(C1=__builtin_amdgcn_mfma_f32_32x32x16_bf16(kf[5],qr[2],C1,0,0,0),   P1[6],P1[7],P1[8],P1[9],     pw2[2]=PKW(P1,4), pw2[3]=PKW(P1,6), pw2); \
    VRD(3); SBAR(); GAPA(C0=__builtin_amdgcn_mfma_f32_32x32x16_bf16(kf[6],qr[3],C0,0,0,0),   P1[10],P1[11],P1[12],P1[13], pw3[0]=PKW(P1,8), pw3[1]=PKW(P1,10), pw3); \
    VRD(7); SBAR(); GAPA(C1=__builtin_amdgcn_mfma_f32_32x32x16_bf16(kf[7],qr[3],C1,0,0,0),   P1[14],P1[15],0.f,0.f,       pw3[2]=PKW(P1,12),pw3[3]=PKW(P1,14), pw3); \
    l_reg+=sacc; \
    if(GK){DMA_K((t)+3,sl_cur);} if(GV){DMA_V((t)+1,sl_next);} \
    CMASK(C0,C1,t); \
    { float a=MX3(C0[0],C0[1],C1[0]),b=MX3(C0[2],C0[3],C1[1]); a=MX3(a,C1[2],C1[3]); \
      _Pragma("unroll") for(int r=4;r<16;r+=4){a=MX3(a,C0[r],C0[r+1]);b=MX3(b,C0[r+2],C0[r+3]);a=MX3(a,C1[r],C1[r+1]);b=MX3(b,C1[r+2],C1[r+3]);} \
      float rm=__builtin_fmaxf(a,b); { auto rr=__builtin_amdgcn_permlane32_swap(__float_as_uint(rm),__float_as_uint(rm),false,false); rm=__builtin_fmaxf(__uint_as_float(rr[0]),__uint_as_float(rr[1])); } \
      resc=false; \
      if(__builtin_expect(__any(rm>(float)THRL),0)){ const float dl=__builtin_fmaxf(rm,0.f); mhat+=dl; \
        _Pragma("unroll") for(int r=0;r<16;++r){C0[r]-=dl;C1[r]-=dl;} \
        _Pragma("unroll") for(int r=0;r<16;++r)negm[r]=-mhat; asm volatile("":"+v"(negm)); \
        const float f=__builtin_amdgcn_exp2f(-dl); l_reg*=f; if(hi==0)wsf[r32]=f; resc=true; } } \
    SBAR(); \
    GAPB(o[0]=__builtin_amdgcn_mfma_f32_32x32x16_bf16(PAF(0),VFR(0),o[0],0,0,0), C0,0); \
    GAPB(o[1]=__builtin_amdgcn_mfma_f32_32x32x16_bf16(PAF(0),VFR(4),o[1],0,0,0), C0,4); \
    KRD(GL,0); GAPB(o[0]=__builtin_amdgcn_mfma_f32_32x32x16_bf16(PAF(1),VFR(1),o[0],0,0,0), C0,8); \
    KRD(GL,1); GAPB(o[1]=__builtin_amdgcn_mfma_f32_32x32x16_bf16(PAF(1),VFR(5),o[1],0,0,0), C0,12); \
    KRD(GL,2); GAPB(o[0]=__builtin_amdgcn_mfma_f32_32x32x16_bf16(PAF(2),VFR(2),o[0],0,0,0), C1,0); \
    KRD(GL,3); GAPB(o[1]=__builtin_amdgcn_mfma_f32_32x32x16_bf16(PAF(2),VFR(6),o[1],0,0,0), C1,4); \
    GAPB(o[0]=__builtin_amdgcn_mfma_f32_32x32x16_bf16(PAF(3),VFR(3),o[0],0,0,0), C1,8); \
    GAPB(o[1]=__builtin_amdgcn_mfma_f32_32x32x16_bf16(PAF(3),VFR(7),o[1],0,0,0), C1,12); \
    }while(0)
  int t=1;
  for(;t+5<NT;t+=2){
    STEP(pB0,pB1,pA0,pA1,t,true,true,true);     WAIT_BAR(2); RESC(); ROT();
    STEP(pA0,pA1,pB0,pB1,t+1,true,true,true);   WAIT_BAR(2); RESC(); ROT();
  }
  #define ENDW(tt) do{ if((tt)+3<NT){WAIT_BAR(2);} else if((tt)+2<NT){WAIT_BAR(1);} else {WAIT_BAR(0);} }while(0)
  for(;t+1<NT;t+=2){
    STEP(pB0,pB1,pA0,pA1,t,(t+3<NT),(t+1<NT),(t+1<NT));       ENDW(t);   RESC(); ROT();
    STEP(pA0,pA1,pB0,pB1,t+1,(t+4<NT),(t+2<NT),(t+2<NT));     ENDW(t+1); RESC(); ROT();
  }
  STEP(pB0,pB1,pA0,pA1,NT-1,false,false,false); RESC();
  { float sacc=pB0[0]+pB0[1]; _Pragma("unroll") for(int r=2;r<16;++r)sacc+=pB0[r]; _Pragma("unroll") for(int r=0;r<16;++r)sacc+=pB1[r]; l_reg+=sacc;
    pw0=(u32x4){PKW(pB0,0),PKW(pB0,2),PKW(pB0,4),PKW(pB0,6)};pw1=(u32x4){PKW(pB0,8),PKW(pB0,10),PKW(pB0,12),PKW(pB0,14)};pw2=(u32x4){PKW(pB1,0),PKW(pB1,2),PKW(pB1,4),PKW(pB1,6)};pw3=(u32x4){PKW(pB1,8),PKW(pB1,10),PKW(pB1,12),PKW(pB1,14)};
    SBAR(); pv(o,vb0+sl_cur,PAF(0),PAF(1),PAF(2),PAF(3)); }
  #undef PKW
  #undef PAF
  #undef VFR
  #undef PIN
  #undef MX3
  #undef GAPA
  #undef GAPB
  #undef EX
  #undef VRD
  #undef KRD
  #undef STEP
  #undef ENDW
  {auto rr=__builtin_amdgcn_permlane32_swap(__float_as_uint(l_reg),__float_as_uint(l_reg),false,false);l_reg=__uint_as_float(rr[0])+__uint_as_float(rr[1]);}
  if(hi==0)wsf[32+r32]=l_reg;asm volatile("s_waitcnt lgkmcnt(0)":::"memory");
  float rli[16];
  #pragma unroll
  for(int r=0;r<16;++r)rli[r]=__builtin_amdgcn_rcpf(wsf[32+crow(r,hi)]);
  bf16*Ow=O+(rowbase+q0+wid*QBLK)*OP+512+h*D;
  { bf16*stg=(bf16*)(shm+LDS_OST)+wid*2048;
    #pragma unroll
    for(int r=0;r<16;++r){const int orow=crow(r,hi);
      #pragma unroll
      for(int d0=0;d0<2;++d0)stg[orow*64+d0*32+r32]=__float2bfloat16(o[d0][r]*rli[r]);}
    asm volatile("s_waitcnt lgkmcnt(0)":::"memory");
    #pragma unroll
    for(int i=0;i<4;++i){const int row=i*8+(lane>>3),ch=lane&7; const u32x4 v=*(const u32x4*)(stg+row*64+ch*8); const u32x4 g=*(const u32x4*)(Ow+(long)row*OP+ch*8); u32x4 w;
      #pragma unroll
      for(int e=0;e<4;++e)w[e]=cvtpk_s(bflo(v[e])*bflo(g[e]),bfhi(v[e])*bfhi(g[e]));
      ATTN_STORE16(Ow+(long)row*OP+ch*8,w);} }
  asm volatile("s_waitcnt lgkmcnt(0)\n\ts_barrier":::"memory");
  #undef DMA_K
  #undef DMA_V
  #undef CMASK
  #undef START
  #undef RESC
  #undef ROT
}
constexpr int ATTN_LDS_BYTES=LDS_BYTES;
#undef SBAR
#undef WAIT_BAR
}
namespace attn_body {
#define SBAR() __builtin_amdgcn_sched_barrier(0)
#define WAIT_BAR(N) asm volatile("s_waitcnt vmcnt(" #N ") lgkmcnt(0)\n\ts_barrier":::"memory")
constexpr int A_K=0, A_V=6*SLOTB, A_WS=12*SLOTB, A_OST=A_WS+NW*64*4, A_LDS_BYTES=A_OST+NW*4096;
constexpr int AP=512;
__device__ __forceinline__ void mixa_unit(long rowbase,int n,int h,int dil,int res,int c,const bf16*Q,const bf16*__restrict__ K,const bf16*__restrict__ V,bf16*PO,float*LSE,char*shm){
  const int tid=threadIdx.x,lane=tid&63,r32=lane&31,hi=lane>>5; const int wid=__builtin_amdgcn_readfirstlane(tid>>6);
  const int L=n/dil, e0=256*c+32*wid, ebase=256*c-64;
  const bool active=e0<L;
  const unsigned lds0=(unsigned)(uintptr_t)shm;
  const bf16*Kh=K+(rowbase+res)*AP+h*D,*Vh=V+(rowbase+res)*AP+h*D; const long estride=(long)dil*AP;
  #pragma unroll
  for(int j=0;j<6;++j){ int e=ebase+64*j+lane; e=e<0?0:(e>L-1?L-1:e);
    glds16(Kh+e*estride+wid*8,(unsigned)__builtin_amdgcn_readfirstlane(lds0+A_K+j*SLOTB+wid*1024)); }
  #pragma unroll
  for(int j=0;j<6;++j){ int e=ebase+64*j+16*(wid&3)+(lane>>2); e=e<0?0:(e>L-1?L-1:e);
    glds16(Vh+e*estride+(wid>>2)*32+(lane&3)*8,(unsigned)__builtin_amdgcn_readfirstlane(lds0+A_V+j*SLOTB+wid*1024)); }
  bf16x8 qr[4]; const int eq=active?e0+r32:0;
  #pragma unroll
  for(int d0=0;d0<4;++d0)qr[d0]=*reinterpret_cast<const bf16x8*>(Q+(rowbase+res)*AP+eq*estride+h*D+d0*16+hi*8);
  WAIT_BAR(0);
  if(active){
    const lds_cptr shm3=(lds_cptr)shm;
    f32x16 s[5];
    #pragma unroll
    for(int kb=0;kb<5;++kb){ const int srel=32*wid+32*kb; const lds_cptr kp=shm3+A_K+(srel>>6)*SLOTB+hi*1024+((srel>>5)&1)*512+r32*16;
      f32x16 a=f32x16{};
      #pragma unroll
      for(int d0=0;d0<4;++d0){ const bf16x8 kf=*(const __attribute__((address_space(3))) bf16x8*)(kp+d0*2048); a=__builtin_amdgcn_mfma_f32_32x32x16_bf16(kf,qr[d0],a,0,0,0); }
      s[kb]=a; }
    const float NEG=-1e30f;
    #pragma unroll
    for(int kb=0;kb<5;++kb){ const int k0=e0-64+32*kb;
      const bool edge=(kb==0)||(kb==4)||(k0<0)||(k0+32>L);
      if(edge){
        #pragma unroll
        for(int r=0;r<16;++r){ const int kv=crow(r,hi), ke=k0+kv; bool ok=(ke>=0)&&(ke<L); if(kb==0)ok=ok&&(kv>=r32); if(kb==4)ok=ok&&(kv<=r32); if(!ok)s[kb][r]=NEG; } } }
    float mx=s[0][0];
    #pragma unroll
    for(int kb=0;kb<5;++kb)
      #pragma unroll
      for(int r=0;r<16;++r)mx=__builtin_fmaxf(mx,s[kb][r]);
    { auto rr=__builtin_amdgcn_permlane32_swap(__float_as_uint(mx),__float_as_uint(mx),false,false); mx=__builtin_fmaxf(__uint_as_float(rr[0]),__uint_as_float(rr[1])); }
    float l=0.f;
    #pragma unroll
    for(int kb=0;kb<5;++kb)
      #pragma unroll
      for(int r=0;r<16;++r){ const float p=__builtin_amdgcn_exp2f(s[kb][r]-mx); s[kb][r]=p; l+=p; }
    { auto rr=__builtin_amdgcn_permlane32_swap(__float_as_uint(l),__float_as_uint(l),false,false); l=__uint_as_float(rr[0])+__uint_as_float(rr[1]); }
    f32x16 o[2]; o[0]=f32x16{}; o[1]=f32x16{};
    #pragma unroll
    for(int kb=0;kb<5;++kb){ const int srel=32*wid+32*kb; const lds_cptr vp=shm3+A_V+(srel>>6)*SLOTB+((lane>>4)&1)*32+(lane&3)*8+(4*hi+((lane&15)>>2))*64+((srel>>5)&1)*2048;
      #pragma unroll
      for(int k=0;k<2;++k){ u32x4 pw; pw[0]=cvtpk_s(s[kb][8*k+0],s[kb][8*k+1]); pw[1]=cvtpk_s(s[kb][8*k+2],s[kb][8*k+3]); pw[2]=cvtpk_s(s[kb][8*k+4],s[kb][8*k+5]); pw[3]=cvtpk_s(s[kb][8*k+6],s[kb][8*k+7]);
        const bf16x8 pa=__builtin_bit_cast(bf16x8,pw);
        #pragma unroll
        for(int d0=0;d0<2;++d0){ const s16x4 vlo=vtr(vp+d0*4096+k*1024), vhi=vtr(vp+d0*4096+k*1024+512);
          const bf16x8 vf=(bf16x8){vlo[0],vlo[1],vlo[2],vlo[3],vhi[0],vhi[1],vhi[2],vhi[3]};
          o[d0]=__builtin_amdgcn_mfma_f32_32x32x16_bf16(pa,vf,o[d0],0,0,0); } } }
    __attribute__((address_space(3))) float*wsf=(__attribute__((address_space(3))) float*)(shm+A_WS)+wid*64;
    if(hi==0)wsf[r32]=l; asm volatile("s_waitcnt lgkmcnt(0)":::"memory");
    float rli[16];
    #pragma unroll
    for(int r=0;r<16;++r)rli[r]=__builtin_amdgcn_rcpf(wsf[crow(r,hi)]);
    const long qrow0=rowbase+res+(long)dil*e0;
    if(hi==0)LSE[(qrow0+(long)dil*r32)*8+h]=mx+__builtin_amdgcn_logf(l);
    { __attribute__((address_space(3))) unsigned short*stg=(__attribute__((address_space(3))) unsigned short*)(shm+A_OST)+wid*2048;
      #pragma unroll
      for(int r=0;r<16;++r){const int orow=crow(r,hi);
        #pragma unroll
        for(int d0=0;d0<2;++d0)stg[orow*64+d0*32+r32]=(unsigned short)f2bf(o[d0][r]*rli[r]);}
      asm volatile("s_waitcnt lgkmcnt(0)":::"memory");
      #pragma unroll
      for(int i=0;i<4;++i){const int row=i*8+(lane>>3),ch=lane&7; const u32x4 v=*(const __attribute__((address_space(3))) u32x4*)(stg+row*64+ch*8); *(u32x4*)(PO+(qrow0+(long)dil*row)*AP+h*D+ch*8)=v;} }
  }
  asm volatile("s_waitcnt lgkmcnt(0)\n\ts_barrier":::"memory");
}
#undef SBAR
#undef WAIT_BAR
}

constexpr int NWAVES = 8;
constexpr int N_PHASES = 6;
constexpr int CW_TMO = 0, CW_CODE = 1;
constexpr int CW_BAR = 4096;
constexpr int RING_OFF = 0, RING_BYTES = 139264;
constexpr int LDSCTL_OFF = RING_BYTES, MISC_OFF = LDSCTL_OFF + 320;
constexpr int LDS_BYTES = 147456;
static_assert(MISC_OFF + 128 <= LDS_BYTES, "LDS map");

#define GAS __attribute__((address_space(1)))
#define LAS __attribute__((address_space(3)))
typedef unsigned v4u __attribute__((ext_vector_type(4)));
typedef float f32x4 __attribute__((ext_vector_type(4)));
typedef GAS unsigned gu32;
#define RLX_AGENT __ATOMIC_RELAXED, __HIP_MEMORY_SCOPE_AGENT
#define LDS_WAIT() asm volatile("s_waitcnt lgkmcnt(0)" ::: "memory")
#define VM_WAIT() asm volatile("s_waitcnt vmcnt(0)" ::: "memory")

#define XB_TMO      128
#define XB_XCNT(j)  (256  + 64 * (j))
#define XB_XSUB(j)  (1280 + 64 * (j))
#define XB_XGEN(j)  (2304 + 64 * (j))
#define XB_TOP      3328
#define XB_TOPGEN   3392
#define XCD_BAR_WORDS 3456
#define XB_SPIN_CAP (1u << 18)

__device__ __forceinline__ unsigned xb_ld(unsigned* p)              { return __hip_atomic_load(p, __ATOMIC_RELAXED, __HIP_MEMORY_SCOPE_AGENT); }
__device__ __forceinline__ unsigned xb_add(unsigned* p, unsigned v) { return __hip_atomic_fetch_add(p, v, __ATOMIC_RELAXED, __HIP_MEMORY_SCOPE_AGENT); }
__device__ __forceinline__ unsigned xb_xcc_id() { return (unsigned)__builtin_amdgcn_s_getreg((3 << 11) | 20) & 0xFu; }
#define XB_SPIN(cond, bar) do { unsigned _sp = 0; while (cond) { __builtin_amdgcn_s_sleep(1); \
    if ((++_sp & 255u) == 0u) { if (xb_ld(&(bar)[XB_TMO])) break; if (_sp > XB_SPIN_CAP) { atomicAdd(&(bar)[XB_TMO], 1u); break; } } } } while (0)

struct XcdBarrier {
    unsigned* bar; unsigned x;
    volatile LAS unsigned* st;
};

__device__ __forceinline__ XcdBarrier xcd_barrier_post(unsigned* bar, volatile LAS unsigned* st) {
    XcdBarrier b; b.bar = bar; b.x = xb_xcc_id(); b.st = st;
    if (threadIdx.x == 0) (void)xb_add(&bar[XB_XCNT(b.x)], 1u);
    return b;
}
__device__ __forceinline__ void xcd_barrier_complete(unsigned* bar, unsigned x, unsigned& nloc, unsigned& nx) {
    const unsigned G = gridDim.x * gridDim.y * gridDim.z;
    unsigned sum, cnt, mine, sp = 0u;
    for (;;) {
        sum = 0u; cnt = 0u; mine = 0u;
#pragma unroll
        for (unsigned j = 0; j < 16; ++j) { const unsigned c = xb_ld(&bar[XB_XCNT(j)]); sum += c; cnt += (c > 0u) ? 1u : 0u; mine = (j == x) ? c : mine; }
        if (sum == G) break;
        __builtin_amdgcn_s_sleep(1);
        if ((++sp & 255u) == 0u) { if (xb_ld(&bar[XB_TMO])) break; if (sp > XB_SPIN_CAP) { atomicAdd(&bar[XB_TMO], 1u); break; } }
    }
    nloc = mine > 0u ? mine : 1u; nx = cnt > 0u ? cnt : 1u;
}

__device__ __forceinline__ void xcd_barrier(const XcdBarrier& b) {
    asm volatile("s_waitcnt vmcnt(0)" ::: "memory");
    __syncthreads();
    if (threadIdx.x == 0) {
        unsigned* bar = b.bar;
        __builtin_amdgcn_s_waitcnt(0);
        unsigned nloc = b.st[0], nx = b.st[1];
        if (nloc == 0u) { xcd_barrier_complete(bar, b.x, nloc, nx); b.st[0] = nloc; b.st[1] = nx; }
        const unsigned old = xb_add(&bar[XB_XSUB(b.x)], 1u);
        const unsigned gen = old / nloc;
        if (old + 1u == (gen + 1u) * nloc) {
            __builtin_amdgcn_fence(__ATOMIC_RELEASE, "agent");
            asm volatile("s_waitcnt vmcnt(0)" ::: "memory");
            const unsigned og = xb_add(&bar[XB_TOP], 1u);
            const unsigned tg = og / nx;
            if (og + 1u == (tg + 1u) * nx) xb_add(&bar[XB_TOPGEN], 1u);
            else XB_SPIN(xb_ld(&bar[XB_TOPGEN]) == tg, bar);
            __builtin_amdgcn_fence(__ATOMIC_ACQUIRE, "agent");
            xb_add(&bar[XB_XGEN(b.x)], 1u);
            asm volatile("s_waitcnt vmcnt(0)" ::: "memory");
        } else {
            XB_SPIN(xb_ld(&bar[XB_XGEN(b.x)]) == gen, bar);
            __builtin_amdgcn_fence(__ATOMIC_ACQUIRE, "agent");
            asm volatile("s_waitcnt vmcnt(0)" ::: "memory");
        }
    }
    __syncthreads();
}

struct Frame {
    LAS unsigned char* lds;
    volatile LAS unsigned* MISC;
    gu32* ctl;
    int tid, lane, wave;
    int vcu, G;
    const float *xp, *xs, *win, *wout, *qn, *kn, *lng, *lnb; float* out;
    float *tab1, *tab2;
    bf16_t *WinT, *WoutT, *XB, *QA, *KA, *VA, *QB, *KB, *VB, *MIX, *PO; float* LSE;
};

__device__ __forceinline__ float wave_sum(float v) {
#pragma unroll
    for (int o = 1; o < 64; o <<= 1) v += __shfl_xor(v, o);
    return v;
}
template <bool PERM> __device__ __forceinline__ void p0_transpose_item(const float* W, int K, int N, bf16_t* WT, LAS float* scr, int item, int lane) {
    const int nblk = N / 32, kb = item / nblk, nb = item % nblk, k0 = 64 * kb, n0 = 32 * nb;
    const int ncol = PERM ? phys2log(n0 + (lane & 31)) : n0 + (lane & 31);
#pragma unroll 8
    for (int i = 0; i < 32; ++i) { const int kk = 2 * i + (lane >> 5); scr[kk * 33 + (lane & 31)] = W[(size_t)(k0 + kk) * N + ncol]; }
    LDS_WAIT(); asm volatile("" ::: "memory");
    const int c = lane & 7;
#pragma unroll
    for (int j = 0; j < 4; ++j) { const int n = (lane >> 3) + 8 * j; const LAS float* s = scr + (8 * c) * 33 + n;
        v4u o; o.x = pk2(s[0 * 33], s[1 * 33]); o.y = pk2(s[2 * 33], s[3 * 33]); o.z = pk2(s[4 * 33], s[5 * 33]); o.w = pk2(s[6 * 33], s[7 * 33]);
        *(GAS v4u*)(WT + (size_t)(n0 + n) * K + k0 + 8 * c) = o; }
    LDS_WAIT(); asm volatile("" ::: "memory");
}
__device__ __forceinline__ void p0_prologue(Frame& F) {
    constexpr double INV1R[32] = {0.15915494309189535, 0.11934937021124886, 0.08949940160889101, 0.06711508300522726, 0.050329212104487035, 0.03774158471741977, 0.0283021958306234, 0.02122365276477766, 0.015915494309189534, 0.011934937021124886, 0.008949940160889102, 0.006711508300522725, 0.005032921210448704, 0.003774158471741977, 0.00283021958306234, 0.0021223652764777662, 0.0015915494309189536, 0.0011934937021124885, 0.0008949940160889102, 0.0006711508300522726, 0.0005032921210448703, 0.00037741584717419774, 0.00028302195830623395, 0.0002122365276477766, 0.00015915494309189535, 0.00011934937021124886, 8.949940160889102e-05, 6.711508300522725e-05, 5.0329212104487035e-05, 3.774158471741978e-05, 2.8302195830623396e-05, 2.122365276477766e-05};
    const int gt = F.vcu * (NWAVES * 64) + F.tid, NGT = F.G * NWAVES * 64;
    for (int i = gt; i < 4096 * 32; i += NGT) { const int pos = i >> 5, f = i & 31; double rev = (double)pos * INV1R[f]; rev -= __builtin_rint(rev); const float r = (float)rev;
        F.tab1[2 * i] = __builtin_amdgcn_cosf(r); F.tab1[2 * i + 1] = __builtin_amdgcn_sinf(r); }
    for (int i = gt; i < 64 * 16; i += NGT) { const int pos = i >> 4, f = i & 15; double rev = (double)pos * INV1R[2 * f]; rev -= __builtin_rint(rev); const float r = (float)rev;
        F.tab2[2 * i] = __builtin_amdgcn_cosf(r); F.tab2[2 * i + 1] = __builtin_amdgcn_sinf(r); }
    LAS float* scr = (LAS float*)(F.lds + RING_OFF + F.wave * 16384);
    const int gw = F.vcu * NWAVES + F.wave, NGW = F.G * NWAVES;
    constexpr int I_IN = (DM / 64) * (NIN / 32), I_OUT = (DM / 64) * (DM / 32);
    for (int it = gw; it < I_IN + I_OUT; it += NGW) {
        if (it < I_IN) p0_transpose_item<true>(F.win, DM, NIN, F.WinT, scr, it, F.lane);
        else p0_transpose_item<false>(F.wout, DM, DM, F.WoutT, scr, it - I_IN, F.lane);
    }
    for (int m = gw; m < M; m += NGW) {
        const GAS f32x4* xr = (const GAS f32x4*)(m < MP ? F.xp + (size_t)m * DM : F.xs + (size_t)(m - MP) * DM) + F.lane;
        GAS unsigned long long* o8 = (GAS unsigned long long*)(F.XB + (size_t)m * DM) + F.lane;
        f32x4 v[4];
#pragma unroll
        for (int j = 0; j < 4; ++j) v[j] = xr[64 * j];
#pragma unroll
        for (int j = 0; j < 4; ++j) o8[64 * j] = (unsigned long long)pk2(v[j].x, v[j].y) | ((unsigned long long)pk2(v[j].z, v[j].w) << 32);
    }
}
__device__ __forceinline__ void p5_layernorm(Frame& F) {
    const int gw = F.vcu * NWAVES + F.wave, NGW = F.G * NWAVES;
    f32x4 gg[4], bb[4];
#pragma unroll
    for (int j = 0; j < 4; ++j) { gg[j] = ((const f32x4*)F.lng)[F.lane + 64 * j]; bb[j] = ((const f32x4*)F.lnb)[F.lane + 64 * j]; }
    for (int m = gw; m < M; m += NGW) {
        GAS f32x4* xr = (GAS f32x4*)(F.out + (size_t)m * DM) + F.lane;
        f32x4 v[4]; float s = 0.f;
#pragma unroll
        for (int j = 0; j < 4; ++j) { v[j] = xr[64 * j]; s += (v[j].x + v[j].y) + (v[j].z + v[j].w); }
        const float mean = wave_sum(s) * (1.f / DM); float s2 = 0.f;
#pragma unroll
        for (int j = 0; j < 4; ++j) { v[j] = v[j] - mean; s2 += (v[j].x * v[j].x + v[j].y * v[j].y) + (v[j].z * v[j].z + v[j].w * v[j].w); }
        const float rstd = 1.f / sqrtf(wave_sum(s2) * (1.f / DM) + LN_EPS);
#pragma unroll
        for (int j = 0; j < 4; ++j) xr[64 * j] = v[j] * rstd * gg[j] + bb[j];
    }
}

#if STAGE >= 3
__device__ __forceinline__ void p2_mixer_a(Frame& F, char* shm) {
    using namespace attn_body;
    const bf16* Q = (const bf16*)F.QA; const bf16* K = (const bf16*)F.KA; const bf16* V = (const bf16*)F.VA;
    for (int s = F.vcu; s < 3584; s += F.G) {
        const int i = s >> 8, x = (s >> 5) & 7, j = s & 31, u = j + 32 * i;
        long rowbase; int n, h, pat, res, c;
        if (u < 192) { const int grp = 4 * x + u / 48, uu = u % 48; rowbase = (long)(grp >> 3) * 4096; n = 4096; h = grp & 7;
            if (uu < 16) { pat = 0; res = 0; c = uu; } else if (uu < 32) { pat = 1; res = (uu - 16) >> 2; c = (uu - 16) & 3; } else { pat = 2; res = uu - 32; c = 0; } }
        else { const int us = u - 192, grp = 8 * x + us / 32, uu = us % 32; rowbase = (long)MP + (long)(grp >> 3) * 2048; n = 2048; h = grp & 7;
            if (uu < 8) { pat = 0; res = 0; c = uu; } else if (uu < 16) { pat = 1; res = (uu - 8) >> 1; c = (uu - 8) & 1; } else { pat = 2; res = uu - 16; c = 0; } }
        mixa_unit(rowbase, n, h, pat == 0 ? 1 : (pat == 1 ? 4 : 16), res, c, Q, K, V, (bf16*)F.PO + (size_t)pat * PO_STRIDE, F.LSE + (size_t)pat * LSE_STRIDE, shm);
    }
}
#endif
__device__ __forceinline__ void p2_attention(Frame& F, char* shm) {
    using namespace attn_body;
    const bf16* Q = (const bf16*)F.QB; const bf16* K = (const bf16*)F.KB; const bf16* V = (const bf16*)F.VB; bf16* O = (bf16*)F.MIX;
#if STAGE >= 3
    p2_mixer_a(F, shm);
#endif
    for (int U = F.vcu; U < 1024; U += F.G) {
        if (U < 512) { const int i = U >> 8, x = (U >> 5) & 7, j = U & 31, u = j + 32 * i;
            attn_unit<8>((long)(x >> 1) * 4096, 4096, (x & 1) * 4 + (u >> 4), u & 15, Q, K, V, O, shm); }
        else { const int Us = U - 512, i = Us >> 8, x = (Us >> 5) & 7, j = Us & 31;
            attn_unit<8>((long)MP + (long)x * 2048, 2048, i * 4 + (j >> 3), j & 7, Q, K, V, O, shm); }
    }
}
#if STAGE >= 3
__device__ __forceinline__ void p3_combine(Frame& F) {
    const int gw = F.vcu * NWAVES + F.wave, NGW = F.G * NWAVES; const int h = F.lane >> 3, ch = F.lane & 7;
    for (int m = gw; m < M; m += NGW) {
        const float l0 = F.LSE[(size_t)m * 8 + h], l1 = F.LSE[LSE_STRIDE + (size_t)m * 8 + h], l2 = F.LSE[2 * LSE_STRIDE + (size_t)m * 8 + h];
        const size_t po = (size_t)m * 512 + h * 64 + ch * 8;
        const v4u a = *(const GAS v4u*)(F.PO + po), b = *(const GAS v4u*)(F.PO + PO_STRIDE + po), c = *(const GAS v4u*)(F.PO + 2 * PO_STRIDE + po);
        GAS v4u* gp = (GAS v4u*)(F.MIX + (size_t)m * DM + h * 64 + ch * 8); const v4u g = *gp;
        const float mx = fmaxf(l0, fmaxf(l1, l2)); float w0 = __builtin_amdgcn_exp2f(l0 - mx), w1 = __builtin_amdgcn_exp2f(l1 - mx), w2 = __builtin_amdgcn_exp2f(l2 - mx);
        const float inv = __builtin_amdgcn_rcpf(w0 + w1 + w2); w0 *= inv; w1 *= inv; w2 *= inv;
        v4u o;
#pragma unroll
        for (int e = 0; e < 4; ++e) { const float lo = (w0 * bflo(a[e]) + w1 * bflo(b[e]) + w2 * bflo(c[e])) * bflo(g[e]), hi = (w0 * bfhi(a[e]) + w1 * bfhi(b[e]) + w2 * bfhi(c[e])) * bfhi(g[e]); o[e] = pk2(lo, hi); }
        *gp = o;
    }
}
#endif

struct Args { const float* in[8]; float* out; unsigned char* ws; int ph_lo, ph_hi, li, pad; };
__global__ void __launch_bounds__(NWAVES * 64, 2) mk_fwd(Args args) {
    extern __shared__ __attribute__((aligned(16))) unsigned char lds[];
    Frame F;
    F.lds = (LAS unsigned char*)lds;
    F.MISC = (volatile LAS unsigned*)(F.lds + MISC_OFF);
    F.tid = threadIdx.x; F.lane = F.tid & 63; F.wave = __builtin_amdgcn_readfirstlane(F.tid >> 6);
    F.G = gridDim.x; { const int bx = blockIdx.x; F.vcu = (F.G % 8 == 0) ? (bx % 8) * (F.G / 8) + bx / 8 : bx; }
    unsigned char* ws = args.ws;
    F.ctl = (gu32*)(ws + WS_CTL);
    F.xp = args.in[0]; F.xs = args.in[1]; F.win = args.in[2]; F.wout = args.in[3]; F.qn = args.in[4]; F.kn = args.in[5]; F.lng = args.in[6]; F.lnb = args.in[7]; F.out = args.out;
    F.tab1 = (float*)(ws + WS_TAB1); F.tab2 = (float*)(ws + WS_TAB2); F.WinT = (bf16_t*)(ws + WS_WIN); F.WoutT = (bf16_t*)(ws + WS_WOUT);
    F.XB = (bf16_t*)((unsigned char*)args.out + DO_XB); F.PO = (bf16_t*)((unsigned char*)args.out + DO_PO); F.LSE = (float*)((unsigned char*)args.out + DO_LSE);
    F.QA = (bf16_t*)(ws + WS_QA); F.KA = (bf16_t*)(ws + WS_KA); F.VA = (bf16_t*)(ws + WS_VA); F.QB = (bf16_t*)(ws + WS_QB); F.KB = (bf16_t*)(ws + WS_KB); F.VB = (bf16_t*)(ws + WS_VB); F.MIX = (bf16_t*)(ws + WS_MIX);
    for (int u = F.tid; u < (LDS_BYTES - LDSCTL_OFF) / 4; u += NWAVES * 64) ((LAS unsigned*)(F.lds + LDSCTL_OFF))[u] = 0u;
    __syncthreads();
    XcdBarrier bar = xcd_barrier_post((unsigned*)(F.ctl + CW_BAR) + args.li * XCD_BAR_WORDS, F.MISC + 8);
    const int lo = args.ph_lo, hi = args.ph_hi;
#define IN(k) (lo <= (k) && (k) < hi)
#define BOTH(k) (IN(k) && IN((k) + 1))
    if (IN(0)) { p0_prologue(F); if (BOTH(0)) xcd_barrier(bar); }
    if (IN(1)) {
        pg8::Gemm g{F.XB, F.WinT, M, NIN, DM}; pg8::StaticOrder S; S.init(M, NIN, F.G, (int)blockIdx.x);
        pg8::EpiG1 E{F.QA, F.KA, F.VA, F.QB, F.KB, F.VB, F.MIX, F.tab1, F.tab2, F.qn, F.kn};
        pg8::gemm_phase<pg8::EpiG1, pg8::StaticOrder, true, true>(F.lds + RING_OFF, g, S, E);
        if (BOTH(1)) xcd_barrier(bar);
    }
#if STAGE >= 2
    if (IN(2)) {
        p2_attention(F, (char*)lds + RING_OFF);
        if (BOTH(2)) xcd_barrier(bar);
    }
#endif
#if STAGE >= 3
    if (IN(3)) { p3_combine(F); if (BOTH(3)) xcd_barrier(bar); }
#endif
#if STAGE >= 4
    if (IN(4)) {
        pg8::Gemm g{F.MIX, F.WoutT, M, DM, DM}; pg8::StaticOrder S; S.init(M, DM, F.G, (int)blockIdx.x);
        pg8::EpiPre E{F.xp, F.xs, F.out};
        pg8::gemm_phase<pg8::EpiPre, pg8::StaticOrder, true, true>(F.lds + RING_OFF, g, S, E);
        if (BOTH(4)) xcd_barrier(bar);
    }
    if (IN(5)) p5_layernorm(F);
#endif
#undef IN
#undef BOTH
}

#if STAGE < 4
typedef unsigned u32x4 __attribute__((ext_vector_type(4)));
struct G1Args { const bf16_t* A; const bf16_t* Bt; bf16_t *qa, *ka, *va, *qb, *kb, *vb, *mix; const float2 *tab1, *tab2; const float *qn, *kn; };
struct G2Args { const bf16_t* A; const bf16_t* Bt; const float *xp, *xs; float* out; };

template <int MODE, class Args> __global__ void __launch_bounds__(256) k_gemm(Args a) {
    __shared__ float As[64][33], Bs[64][33], Cs[64][65];
    const int tid = threadIdx.x, tx = tid & 15, ty = tid >> 4;
    const int row0 = blockIdx.x * 64, slot = blockIdx.y;
    const int pn = slot >> 2, wc = slot & 3;
    float acc[4][4];
#pragma unroll
    for (int i = 0; i < 4; ++i)
#pragma unroll
        for (int j = 0; j < 4; ++j) acc[i][j] = 0.f;
    const int lr = tid >> 2, kc = (tid & 3) * 8;
    int bcol;
    if (MODE == 1) bcol = 256 * pn + 128 * (lr >> 5) + 32 * wc + (lr & 31); else bcol = 64 * slot + lr;
    for (int k0 = 0; k0 < DM; k0 += 32) {
        const u32x4 av = *(const u32x4*)(a.A + (size_t)(row0 + lr) * DM + k0 + kc);
        const u32x4 bv = *(const u32x4*)(a.Bt + (size_t)bcol * DM + k0 + kc);
        __syncthreads();
#pragma unroll
        for (int e = 0; e < 4; ++e) { As[lr][kc + 2 * e] = bf2f(av[e] & 0xffffu); As[lr][kc + 2 * e + 1] = bf2f(av[e] >> 16); Bs[lr][kc + 2 * e] = bf2f(bv[e] & 0xffffu); Bs[lr][kc + 2 * e + 1] = bf2f(bv[e] >> 16); }
        __syncthreads();
#pragma unroll 8
        for (int k = 0; k < 32; ++k) {
            float av4[4], bv4[4];
#pragma unroll
            for (int i = 0; i < 4; ++i) { av4[i] = As[4 * ty + i][k]; bv4[i] = Bs[tx + 16 * i][k]; }
#pragma unroll
            for (int i = 0; i < 4; ++i)
#pragma unroll
                for (int j = 0; j < 4; ++j) acc[i][j] += av4[i] * bv4[j];
        }
    }
#pragma unroll
    for (int i = 0; i < 4; ++i)
#pragma unroll
        for (int j = 0; j < 4; ++j) Cs[4 * ty + i][tx + 16 * j] = acc[i][j];
    __syncthreads();
    const int r = tid >> 2, q4 = tid & 3, m = row0 + r;
    if constexpr (MODE == 2) {
        const float* xr = m < MP ? a.xp + (size_t)m * DM : a.xs + (size_t)(m - MP) * DM;
        for (int e = 0; e < 16; ++e) { const int lc = 16 * q4 + e, col = 64 * slot + lc; a.out[(size_t)m * DM + col] = ALPHA * xr[col] + Cs[r][lc]; }
    } else {
        int n, t, base; tok(m, n, t, base);
        int kind, head;
        if (pn < 2) { kind = 0; head = 4 * pn + wc; } else if (pn < 4) { kind = 1; head = 4 * (pn - 2) + wc; } else if (pn < 6) { kind = 2; head = 4 * (pn - 4) + wc; }
        else if (pn < 8) { kind = 3; head = 4 * (pn - 6) + wc; } else if (pn < 10) { kind = 4; head = 4 * (pn - 8) + wc; } else if (pn < 12) { kind = 5; head = 4 * (pn - 10) + wc; }
        else if (wc < 2) { kind = 6; head = wc; } else { kind = 7; head = wc - 2; }
        if (kind == 0 || kind == 1) {
            bf16_t* dst = (kind == 0 ? a.qa : a.ka) + (size_t)m * 512 + head * 64; const float sc = kind == 0 ? C2 : 1.f;
            for (int e = 0; e < 8; ++e) { const int i = 8 * q4 + e; const float2 cs = a.tab1[t * 32 + i]; const float x1 = Cs[r][i], x2 = Cs[r][32 + i];
                dst[i] = (bf16_t)f2bf((x1 * cs.x - x2 * cs.y) * sc); dst[32 + i] = (bf16_t)f2bf((x2 * cs.x + x1 * cs.y) * sc); }
        } else if (kind == 2 || kind == 7) {
            bf16_t* dst = kind == 2 ? a.va + (size_t)m * 512 + head * 64 : a.vb + (size_t)m * 128 + head * 64;
            for (int e = 0; e < 16; ++e) { const int lc = 16 * q4 + e; dst[lc] = (bf16_t)f2bf(Cs[r][lc]); }
        } else if (kind == 3 || kind == 5) {
            bf16_t* dst = a.mix + (size_t)m * DM + (kind == 5 ? 512 : 0) + head * 64;
            for (int e = 0; e < 16; ++e) { const int lc = 16 * q4 + e; const float g = Cs[r][lc]; dst[lc] = (bf16_t)f2bf(g / (1.f + __expf(-g))); }
        } else {
            float ss = 0.f;
            for (int e = 0; e < 16; ++e) { const float v = Cs[r][16 * q4 + e]; ss += v * v; }
            ss += __shfl_xor(ss, 1); ss += __shfl_xor(ss, 2);
            const float rs = 1.0f / sqrtf(ss * (1.f / 64.f) + 1e-6f);
            const float* gn = kind == 4 ? a.qn : a.kn; const float sc = kind == 4 ? C2 : 1.f;
            bf16_t* dst = kind == 4 ? a.qb + (size_t)m * 512 + head * 64 : a.kb + (size_t)m * 128 + head * 64;
            const int prow = t >> 6, pcol = t & 63;
            for (int e = 0; e < 8; ++e) { const int i = 8 * q4 + e, d1 = axdim(0, i), d2 = axdim(1, i);
                const float2 cs = a.tab2[(i < 16 ? prow : pcol) * 16 + (i & 15)];
                const float x1 = Cs[r][i] * rs * gn[d1], x2 = Cs[r][32 + i] * rs * gn[d2];
                dst[d1] = (bf16_t)f2bf((x1 * cs.x - x2 * cs.y) * sc); dst[d2] = (bf16_t)f2bf((x2 * cs.x + x1 * cs.y) * sc); }
        }
    }
}

__global__ void __launch_bounds__(256) k_attn_a(const bf16_t* qa, const bf16_t* ka, const bf16_t* va, bf16_t* mix) {
    const int gid = blockIdx.x * 256 + threadIdx.x; const int h = gid & 7, m = gid >> 3;
    if (m >= M) return;
    int n, t, base; tok(m, n, t, base);
    float q[64], o[64];
    const bf16_t* qp = qa + (size_t)m * 512 + h * 64;
#pragma unroll
    for (int d = 0; d < 64; ++d) { q[d] = bf2f(qp[d]); o[d] = 0.f; }
    float mx = -1e30f, l = 0.f;
    for (int p = 0; p < 3; ++p) { const int dil = p == 0 ? 1 : (p == 1 ? 4 : 16);
        for (int j = -64; j <= 64; ++j) { const int kp = t + dil * j; if (kp < 0 || kp >= n) continue;
            const bf16_t* kr = ka + (size_t)(base + kp) * 512 + h * 64; const bf16_t* vr = va + (size_t)(base + kp) * 512 + h * 64;
            float s = 0.f;
#pragma unroll
            for (int d = 0; d < 64; ++d) s += q[d] * bf2f(kr[d]);
            const float mn = fmaxf(mx, s), f = exp2f(mx - mn), pe = exp2f(s - mn);
            l = l * f + pe;
#pragma unroll
            for (int d = 0; d < 64; ++d) o[d] = o[d] * f + pe * bf2f(vr[d]);
            mx = mn; } }
    bf16_t* mp = mix + (size_t)m * DM + h * 64; const float il = 1.f / l;
#pragma unroll
    for (int d = 0; d < 64; ++d) mp[d] = (bf16_t)f2bf(o[d] * il * bf2f(mp[d]));
}

__global__ void __launch_bounds__(256) k_attn_b(const bf16_t* qb, const bf16_t* kb, const bf16_t* vb, bf16_t* mix) {
    __shared__ float Ks[64][64], Vs[64][64];
    const int tid = threadIdx.x; const int h = blockIdx.y, kvh = h >> 2; const int m = blockIdx.x * 256 + tid;
    int n, t, base; tok(m, n, t, base);
    float q[64], o[64];
    const bf16_t* qp = qb + (size_t)m * 512 + h * 64;
#pragma unroll
    for (int d = 0; d < 64; ++d) { q[d] = bf2f(qp[d]); o[d] = 0.f; }
    float mx = -1e30f, l = 0.f;
    for (int k0 = 0; k0 < n; k0 += 64) {
        __syncthreads();
        { const int kr = tid >> 2, c0 = (tid & 3) * 16; const bf16_t* kp = kb + (size_t)(base + k0 + kr) * 128 + kvh * 64 + c0; const bf16_t* vp = vb + (size_t)(base + k0 + kr) * 128 + kvh * 64 + c0;
            for (int e = 0; e < 16; ++e) { Ks[kr][c0 + e] = bf2f(kp[e]); Vs[kr][c0 + e] = bf2f(vp[e]); } }
        __syncthreads();
        for (int j = 0; j < 64; ++j) {
            float s = 0.f;
#pragma unroll
            for (int d = 0; d < 64; ++d) s += q[d] * Ks[j][d];
            const float mn = fmaxf(mx, s), f = exp2f(mx - mn), pe = exp2f(s - mn);
            l = l * f + pe;
#pragma unroll
            for (int d = 0; d < 64; ++d) o[d] = o[d] * f + pe * Vs[j][d];
            mx = mn;
        }
    }
    bf16_t* mp = mix + (size_t)m * DM + 512 + h * 64; const float il = 1.f / l;
#pragma unroll
    for (int d = 0; d < 64; ++d) mp[d] = (bf16_t)f2bf(o[d] * il * bf2f(mp[d]));
}

__global__ void __launch_bounds__(256) k_ln(float* out, const float* g, const float* b) {
    const int lane = threadIdx.x & 63, row = blockIdx.x * 4 + (threadIdx.x >> 6);
    f32x4* xr = (f32x4*)(out + (size_t)row * DM) + lane;
    f32x4 v[4]; float s = 0.f;
#pragma unroll
    for (int j = 0; j < 4; ++j) { v[j] = xr[64 * j]; s += (v[j].x + v[j].y) + (v[j].z + v[j].w); }
#pragma unroll
    for (int o = 1; o < 64; o <<= 1) s += __shfl_xor(s, o);
    const float mean = s * (1.f / DM); float s2 = 0.f;
#pragma unroll
    for (int j = 0; j < 4; ++j) { v[j] = v[j] - mean; s2 += (v[j].x * v[j].x + v[j].y * v[j].y) + (v[j].z * v[j].z + v[j].w * v[j].w); }
#pragma unroll
    for (int o = 1; o < 64; o <<= 1) s2 += __shfl_xor(s2, o);
    const float rstd = 1.f / sqrtf(s2 * (1.f / DM) + 1e-5f);
#pragma unroll
    for (int j = 0; j < 4; ++j) { const f32x4 gg = ((const f32x4*)g)[lane + 64 * j], bb = ((const f32x4*)b)[lane + 64 * j]; xr[64 * j] = v[j] * rstd * gg + bb; }
}

#endif

extern "C" void kernel_launch(void* const* d_in, const int* in_sizes, int n_in, void* d_out, int out_size, void* d_ws, size_t ws_size, hipStream_t stream) {
    static int grid = 0;
    if (grid == 0) {
        if (n_in != 8 || in_sizes[0] != MP * DM || in_sizes[2] != DM * NIN || out_size != M * DM || ws_size < WS_END) { fprintf(stderr, "kernel_launch: unexpected shapes (n_in %d in0 %d in2 %d out %d ws %zu); nothing launched\n", n_in, n_in > 0 ? in_sizes[0] : -1, n_in > 2 ? in_sizes[2] : -1, out_size, ws_size); grid = -1; return; }
        int dev = 0, cus = 0, per_cu = 0;
        if (hipGetDevice(&dev) != hipSuccess || hipDeviceGetAttribute(&cus, hipDeviceAttributeMultiprocessorCount, dev) != hipSuccess) { grid = -1; return; }
        if (hipFuncSetAttribute((const void*)mk_fwd, hipFuncAttributeMaxDynamicSharedMemorySize, LDS_BYTES) != hipSuccess) { fprintf(stderr, "kernel_launch: hipFuncSetAttribute failed\n"); grid = -1; return; }
        if (hipOccupancyMaxActiveBlocksPerMultiprocessor(&per_cu, (const void*)mk_fwd, NWAVES * 64, LDS_BYTES) != hipSuccess || per_cu < 1) { fprintf(stderr, "kernel_launch: occupancy query reports %d workgroups per CU\n", per_cu); (void)hipGetLastError(); grid = -1; return; }
        grid = cus;
    }
    if (grid < 0) return;
    if (hipMemsetAsync((char*)d_ws + WS_CTL, 0, CTL_ZERO_BYTES, stream) != hipSuccess) return;
    Args a{};
    for (int i = 0; i < 8; ++i) a.in[i] = (const float*)d_in[i];
    a.out = (float*)d_out; a.ws = (unsigned char*)d_ws;
#if STAGE >= 4
    a.ph_lo = 0; a.ph_hi = N_PHASES; a.li = 0;
    hipLaunchKernelGGL(mk_fwd, dim3(grid), dim3(NWAVES * 64), LDS_BYTES, stream, a);
#else
    unsigned char* ws = (unsigned char*)d_ws;
    bf16_t *qa = (bf16_t*)(ws + WS_QA), *ka = (bf16_t*)(ws + WS_KA), *va = (bf16_t*)(ws + WS_VA), *qb = (bf16_t*)(ws + WS_QB), *kb = (bf16_t*)(ws + WS_KB), *vb = (bf16_t*)(ws + WS_VB), *mix = (bf16_t*)(ws + WS_MIX);
    a.ph_lo = 0; a.ph_hi = STAGE + 1; a.li = 0;
    hipLaunchKernelGGL(mk_fwd, dim3(grid), dim3(NWAVES * 64), LDS_BYTES, stream, a);
#if STAGE < 3
    k_attn_a<<<(M * 8) / 256, 256, 0, stream>>>(qa, ka, va, mix);
#endif
#if STAGE < 2
    k_attn_b<<<dim3(M / 256, 8), 256, 0, stream>>>(qb, kb, vb, mix);
#endif
    G2Args g2{mix, (const bf16_t*)(ws + WS_WOUT), (const float*)d_in[0], (const float*)d_in[1], (float*)d_out};
    k_gemm<2, G2Args><<<dim3(M / 64, 16), 256, 0, stream>>>(g2);
    k_ln<<<M / 4, 256, 0, stream>>>((float*)d_out, (const float*)d_in[6], (const float*)d_in[7]);
#endif
}
```
